# Optimizing an MI355X kernel written in HIP

```python
import math
import jax, jax.numpy as jnp
from jax import lax
import numpy as np

D_MODEL = 1024
BATCH = 16
SEQ = 2048
DEPTH = 1

NSA_HEADS = 8
NSA_KV_HEADS = 2
NSA_GROUP = NSA_HEADS // NSA_KV_HEADS
HEAD_DIM = 64
CMP_BLOCK = 32
CMP_STRIDE = 16
CMP_HIDDEN = 256
SEL_BLOCK = 64
SEL_TOPK = 8
WINDOW = 256
WIN_QBLOCK = 128
FORCE_SCORE = 1.0e4
RET_HEADS = 4
RET_QK_DIM = 64
RET_V_DIM = 128
RET_CHUNK = 128
D_FF = 4 * D_MODEL
ROPE_THETA = 10000.0
EPS = 1e-6
NEG_INF = -1.0e30

NSA_Q_DIM = NSA_HEADS * HEAD_DIM
NSA_KV_DIM = NSA_KV_HEADS * HEAD_DIM
NSA_GATE_DIM = 3 * NSA_HEADS
RET_QK_WIDTH = RET_HEADS * RET_QK_DIM
RET_V_WIDTH = RET_HEADS * RET_V_DIM
MIX_WIDTH = NSA_Q_DIM + RET_V_WIDTH
IN_SIZES = [NSA_Q_DIM, NSA_KV_DIM, NSA_KV_DIM, NSA_KV_DIM, NSA_KV_DIM, NSA_KV_DIM, NSA_KV_DIM,
            NSA_GATE_DIM, RET_QK_WIDTH, RET_QK_WIDTH, RET_V_WIDTH, RET_V_WIDTH]
IN_WIDTH = sum(IN_SIZES)

kernel_name = "hybrid_nsa_retention_sqrelu"


def rms_norm(x, w):
    xf = x.astype(jnp.float32)
    y = xf * lax.rsqrt(jnp.mean(xf * xf, axis=-1, keepdims=True) + EPS)
    return (y * w.astype(jnp.float32)).astype(x.dtype)


def rope(x, pos):
    half = x.shape[-1] // 2
    inv = ROPE_THETA ** (-jnp.arange(half, dtype=jnp.float32) / half)
    ang = pos.astype(jnp.float32)[:, None] * inv[None, :]
    cos, sin = jnp.cos(ang), jnp.sin(ang)
    xf = x.astype(jnp.float32)
    x1, x2 = xf[..., :half], xf[..., half:]
    return jnp.concatenate([x1 * cos - x2 * sin, x2 * cos + x1 * sin], axis=-1).astype(x.dtype)


def masked_softmax(s, mask):
    s = jnp.where(mask, s.astype(jnp.float32), NEG_INF)
    p = jax.nn.softmax(s, axis=-1)
    return jnp.where(mask, p, 0.0)


def compress(blocks, w1, w2):
    b, g, n, l, d = blocks.shape
    return jax.nn.silu(blocks.reshape(b, g, n, l * d) @ w1) @ w2


def nsa_mixer(q, kc, vc, ks, vs, kw, vw, gates, q_norm_w, k_norm_w,
              cmp_pe_k, cmp_pe_v, cmp_wk1, cmp_wk2, cmp_wv1, cmp_wv2):
    B, S, _ = q.shape
    G, R, dh = NSA_KV_HEADS, NSA_GROUP, HEAD_DIM
    pos = jnp.arange(S)
    scale = dh ** -0.5
    q = q.reshape(B, S, G, R, dh).transpose(0, 2, 3, 1, 4)
    q = rope(rms_norm(q, q_norm_w), pos)

    def prep_k(k, w):
        k = k.reshape(B, S, G, dh).transpose(0, 2, 1, 3)
        return rope(rms_norm(k, w), pos)

    def prep_v(v):
        return v.reshape(B, S, G, dh).transpose(0, 2, 1, 3)

    kc, ks, kw = prep_k(kc, k_norm_w[0]), prep_k(ks, k_norm_w[1]), prep_k(kw, k_norm_w[2])
    vc, vs, vw = prep_v(vc), prep_v(vs), prep_v(vw)

    n_cmp = (S - CMP_BLOCK) // CMP_STRIDE + 1
    c_start = jnp.arange(n_cmp) * CMP_STRIDE
    cidx = c_start[:, None] + jnp.arange(CMP_BLOCK)[None, :]
    k_cmp = compress(kc[:, :, cidx] + cmp_pe_k, cmp_wk1, cmp_wk2)
    v_cmp = compress(vc[:, :, cidx] + cmp_pe_v, cmp_wv1, cmp_wv2)
    s_cmp = jnp.einsum('bgrqd,bgcd->bgrqc', q, k_cmp) * scale
    cmask = (c_start + CMP_BLOCK - 1)[None, :] <= pos[:, None]
    p_cmp = masked_softmax(s_cmp, cmask)
    o_cmp = jnp.einsum('bgrqc,bgcd->bgrqd', p_cmp.astype(v_cmp.dtype), v_cmp)

    n_blk = S // SEL_BLOCK
    jb = jnp.arange(n_blk)
    overlap = ((c_start[:, None] < (jb[None, :] + 1) * SEL_BLOCK)
               & (c_start[:, None] + CMP_BLOCK > jb[None, :] * SEL_BLOCK)).astype(jnp.float32)
    p_slc = jnp.einsum('bgrqc,cj->bgqj', p_cmp, overlap)
    cur = pos // SEL_BLOCK
    forced = (jb[None, :] == 0) | (jb[None, :] == cur[:, None]) | (jb[None, :] == cur[:, None] - 1)
    valid = jb[None, :] <= cur[:, None]
    score = jnp.where(forced, FORCE_SCORE, jnp.where(valid, p_slc, -1.0))
    n_sel = min(SEL_TOPK, n_blk)
    _, sel_idx = lax.top_k(score, n_sel)

    k_blocks = ks.reshape(B, G, n_blk, SEL_BLOCK, dh)
    v_blocks = vs.reshape(B, G, n_blk, SEL_BLOCK, dh)
    nq = S // SEL_BLOCK
    q_b = jnp.moveaxis(q.reshape(B, G, R, nq, SEL_BLOCK, dh), 3, 0)
    idx_b = jnp.moveaxis(sel_idx.reshape(B, G, nq, SEL_BLOCK, n_sel), 2, 0)
    t_b = pos.reshape(nq, SEL_BLOCK)
    bi = jnp.arange(B)[:, None, None, None]
    gi = jnp.arange(G)[None, :, None, None]
    n_keys = n_sel * SEL_BLOCK

    def sel_block(args):
        qc, ic, tc = args
        ksel = k_blocks[bi, gi, ic]
        vsel = v_blocks[bi, gi, ic]
        s = jnp.einsum('bgrqd,bgqnkd->bgrqnk', qc, ksel) * scale
        kpos = ic[..., None] * SEL_BLOCK + jnp.arange(SEL_BLOCK)
        mask = (kpos <= tc[None, None, :, None, None])[:, :, None]
        p = masked_softmax(s.reshape(B, G, R, SEL_BLOCK, n_keys),
                           mask.reshape(B, G, 1, SEL_BLOCK, n_keys))
        return jnp.einsum('bgrqk,bgqkd->bgrqd', p.astype(vsel.dtype),
                          vsel.reshape(B, G, SEL_BLOCK, n_keys, dh))

    o_sel = lax.map(sel_block, (q_b, idx_b, t_b))
    o_sel = jnp.moveaxis(o_sel, 0, 3).reshape(B, G, R, S, dh)

    nw = S // WIN_QBLOCK
    n_wk = WIN_QBLOCK + WINDOW
    widx = jnp.arange(nw)[:, None] * WIN_QBLOCK + jnp.arange(n_wk)[None, :]
    pad = ((0, 0), (0, 0), (WINDOW, 0), (0, 0))
    kwin = jnp.pad(kw, pad)[:, :, widx]
    vwin = jnp.pad(vw, pad)[:, :, widx]
    kpos = widx - WINDOW
    qw = q.reshape(B, G, R, nw, WIN_QBLOCK, dh)
    s_w = jnp.einsum('bgrcqd,bgckd->bgrcqk', qw, kwin) * scale
    tq = pos.reshape(nw, WIN_QBLOCK)
    diff = tq[:, :, None] - kpos[:, None, :]
    wmask = (diff >= 0) & (diff < WINDOW) & (kpos[:, None, :] >= 0)
    p_w = masked_softmax(s_w, wmask)
    o_win = jnp.einsum('bgrcqk,bgckd->bgrcqd', p_w.astype(vwin.dtype), vwin).reshape(B, G, R, S, dh)

    g = jax.nn.sigmoid(gates.astype(jnp.float32)).reshape(B, S, 3, G, R)
    g = g.transpose(2, 0, 3, 4, 1)[..., None].astype(q.dtype)
    o = g[0] * o_cmp + g[1] * o_sel + g[2] * o_win
    return o.transpose(0, 3, 1, 2, 4).reshape(B, S, NSA_Q_DIM)


def retention_mixer(q, k, v, gate, ret_norm_w):
    B, S, _ = q.shape
    H, dk, dv, C = RET_HEADS, RET_QK_DIM, RET_V_DIM, RET_CHUNK
    out_dtype = q.dtype
    pos = jnp.arange(S)
    q = rope(q.reshape(B, S, H, dk).transpose(0, 2, 1, 3), pos).astype(jnp.float32)
    k = (rope(k.reshape(B, S, H, dk).transpose(0, 2, 1, 3), pos).astype(jnp.float32)) * (dk ** -0.5)
    v = v.reshape(B, S, H, dv).transpose(0, 2, 1, 3).astype(jnp.float32)

    log_gamma = jnp.log(1.0 - 2.0 ** (-5.0 - jnp.arange(H, dtype=jnp.float32)))
    i = jnp.arange(C)
    d_int = i[:, None] - i[None, :]
    dmat = jnp.where(d_int >= 0,
                     jnp.exp(log_gamma[:, None, None] * jnp.maximum(d_int, 0).astype(jnp.float32)), 0.0)
    xi = jnp.exp(log_gamma[:, None] * (i + 1).astype(jnp.float32))[..., None]
    zeta = jnp.exp(log_gamma[:, None] * (C - 1 - i).astype(jnp.float32))[..., None]
    gamma_c = jnp.exp(log_gamma * C)[:, None, None]

    nc = S // C
    to_chunks = lambda t: jnp.moveaxis(t.reshape(B, H, nc, C, t.shape[-1]), 2, 0)

    def step(state, inp):
        qc, kc, vc = inp
        inner = jnp.einsum('bhqd,bhkd->bhqk', qc, kc) * dmat
        y = (jnp.einsum('bhqk,bhkv->bhqv', inner, vc)
             + jnp.einsum('bhqd,bhdv->bhqv', qc, state) * xi)
        state = gamma_c * state + jnp.einsum('bhkd,bhkv->bhdv', kc * zeta, vc)
        return state, y

    state0 = jnp.zeros((B, H, dk, dv), jnp.float32)
    _, y = lax.scan(step, state0, (to_chunks(q), to_chunks(k), to_chunks(v)))
    y = jnp.moveaxis(y, 0, 2).reshape(B, H, S, dv)
    mu = jnp.mean(y, axis=-1, keepdims=True)
    var = jnp.mean(jnp.square(y - mu), axis=-1, keepdims=True)
    y = (y - mu) * lax.rsqrt(var + EPS) * ret_norm_w.astype(jnp.float32)[None, :, None, :]
    y = y.transpose(0, 2, 1, 3).reshape(B, S, RET_V_WIDTH)
    return (jax.nn.silu(gate.astype(jnp.float32)) * y).astype(out_dtype)


def setup_inputs(seed: int = 0) -> dict:
    key = jax.random.key(seed)
    ks = jax.random.split(key, 16)
    nrm = lambda k, shape, s: jax.random.normal(k, shape, jnp.float32) * s
    L = DEPTH
    return {
        "x": nrm(ks[0], (BATCH, SEQ, D_MODEL), 1.0),
        "ln1_w": 1.0 + nrm(ks[1], (L, D_MODEL), 0.02),
        "w_in": nrm(ks[2], (L, D_MODEL, IN_WIDTH), D_MODEL ** -0.5),
        "q_norm_w": 1.0 + nrm(ks[3], (L, HEAD_DIM), 0.02),
        "k_norm_w": 1.0 + nrm(ks[4], (L, 3, HEAD_DIM), 0.02),
        "cmp_pe_k": nrm(ks[5], (L, CMP_BLOCK, HEAD_DIM), 0.02),
        "cmp_pe_v": nrm(ks[6], (L, CMP_BLOCK, HEAD_DIM), 0.02),
        "cmp_wk1": nrm(ks[7], (L, CMP_BLOCK * HEAD_DIM, CMP_HIDDEN), (CMP_BLOCK * HEAD_DIM) ** -0.5),
        "cmp_wk2": nrm(ks[8], (L, CMP_HIDDEN, HEAD_DIM), CMP_HIDDEN ** -0.5),
        "cmp_wv1": nrm(ks[9], (L, CMP_BLOCK * HEAD_DIM, CMP_HIDDEN), (CMP_BLOCK * HEAD_DIM) ** -0.5),
        "cmp_wv2": nrm(ks[10], (L, CMP_HIDDEN, HEAD_DIM), CMP_HIDDEN ** -0.5),
        "ret_norm_w": 1.0 + nrm(ks[11], (L, RET_HEADS, RET_V_DIM), 0.02),
        "w_out": nrm(ks[12], (L, MIX_WIDTH, D_MODEL), MIX_WIDTH ** -0.5),
        "ln2_w": 1.0 + nrm(ks[13], (L, D_MODEL), 0.02),
        "w_up": nrm(ks[14], (L, D_MODEL, D_FF), D_MODEL ** -0.5),
        "w_down": nrm(ks[15], (L, D_FF, D_MODEL), D_FF ** -0.5),
    }


def reference(x, ln1_w, w_in, q_norm_w, k_norm_w, cmp_pe_k, cmp_pe_v, cmp_wk1, cmp_wk2,
              cmp_wv1, cmp_wv2, ret_norm_w, w_out, ln2_w, w_up, w_down):
    split_points = [int(p) for p in np.cumsum(IN_SIZES)[:-1]]
    h = x
    for l in range(DEPTH):
        xn = rms_norm(h, ln1_w[l])
        proj = xn @ w_in[l]
        (nq_, nkc, nvc, nks, nvs, nkw, nvw, ngate,
         rq, rk, rv, rg) = jnp.split(proj, split_points, axis=-1)
        o_nsa = nsa_mixer(nq_, nkc, nvc, nks, nvs, nkw, nvw, ngate, q_norm_w[l], k_norm_w[l],
                          cmp_pe_k[l], cmp_pe_v[l], cmp_wk1[l], cmp_wk2[l], cmp_wv1[l], cmp_wv2[l])
        o_ret = retention_mixer(rq, rk, rv, rg, ret_norm_w[l])
        mix = jnp.concatenate([o_nsa, o_ret], axis=-1)
        h = h + mix @ w_out[l]
        hn = rms_norm(h, ln2_w[l])
        h = h + jnp.square(jax.nn.relu(hn @ w_up[l])) @ w_down[l]
    return h
```

```cpp
#include <hip/hip_runtime.h>
#include <hip/hip_bf16.h>
#include <hip/hip_cooperative_groups.h>
#include <cstdio>
namespace cg = cooperative_groups;

typedef unsigned short bfu;
using bf16x8 = __attribute__((ext_vector_type(8))) short;
using f32x4 = __attribute__((ext_vector_type(4))) float;
#define DI __device__ __forceinline__

constexpr int NB = 16, SQ = 2048, DM = 1024, TT = NB * SQ;
constexpr int DFF = 4096;
constexpr int NIN = 2840, NINP = 3072;
constexpr float EPSF = 1e-6f;
constexpr float LOG2E_C = 1.4426950408889634f;

constexpr size_t al256(size_t x) { return (x + 255) & ~(size_t)255; }
constexpr size_t O_WINT = 0;
constexpr size_t O_WOUTT = O_WINT + al256((size_t)NINP * 1024 * 2);
constexpr size_t O_WUPT = O_WOUTT + al256((size_t)1024 * 1024 * 2);
constexpr size_t O_WDOWNT = O_WUPT + al256((size_t)4096 * 1024 * 2);
constexpr size_t O_WK1T = O_WDOWNT + al256((size_t)1024 * 4096 * 2);
constexpr size_t O_WV1T = O_WK1T + al256((size_t)256 * 2048 * 2);
constexpr size_t O_WK2T = O_WV1T + al256((size_t)256 * 2048 * 2);
constexpr size_t O_WV2T = O_WK2T + al256((size_t)128 * 256 * 2);
constexpr size_t O_B1K = O_WV2T + al256((size_t)128 * 256 * 2);
constexpr size_t O_B1V = O_B1K + 1024;
constexpr size_t O_ROPEC = O_B1V + 1024;
constexpr size_t O_ROPES = O_ROPEC + (size_t)2048 * 32 * 4;
constexpr size_t O_XN = O_ROPES + (size_t)2048 * 32 * 4;
constexpr size_t O_QN = O_XN + (size_t)TT * 1024 * 2;
constexpr size_t O_KC = O_QN + (size_t)TT * 512 * 2;
constexpr size_t O_VC = O_KC + (size_t)TT * 128 * 2;
constexpr size_t O_KS = O_VC + (size_t)TT * 128 * 2;
constexpr size_t O_VST = O_KS + (size_t)TT * 128 * 2;
constexpr size_t O_KW = O_VST + (size_t)TT * 128 * 2;
constexpr size_t O_VWT = O_KW + (size_t)TT * 128 * 2;
constexpr size_t O_RQ = O_VWT + (size_t)TT * 128 * 2;
constexpr size_t O_RQX = O_RQ + (size_t)TT * 256 * 2;
constexpr size_t O_RK = O_RQX + (size_t)TT * 256 * 2;
constexpr size_t O_RKTZ = O_RK + (size_t)TT * 256 * 2;
constexpr size_t O_RVT = O_RKTZ + (size_t)TT * 256 * 2;
constexpr size_t O_RG = O_RVT + (size_t)TT * 512 * 2;
constexpr size_t O_GT = O_RG + (size_t)TT * 512 * 2;
constexpr size_t O_MIX = O_GT + (size_t)TT * 24 * 4;
constexpr size_t O_HK = O_MIX + (size_t)TT * 1024 * 2;
constexpr size_t O_HV = O_HK + (size_t)4096 * 256 * 2;
constexpr size_t O_KCMP = O_HV + (size_t)4096 * 256 * 2;
constexpr size_t O_VCMPT = O_KCMP + (size_t)32 * 128 * 64 * 2;
constexpr size_t O_KVT = O_VCMPT + (size_t)32 * 128 * 64 * 2;
constexpr size_t O_ONSA = O_KVT + (size_t)1024 * 128 * 64 * 4;
constexpr size_t O_END = O_ONSA + (size_t)TT * 512 * 4;
constexpr size_t O_HACC = O_ONSA;
constexpr size_t O_SS2 = O_ONSA + (size_t)40 * 1024 * 1024;
constexpr size_t O_B1P = O_ONSA + (size_t)44 * 1024 * 1024;
constexpr size_t O_BAR = O_ONSA + (size_t)45 * 1024 * 1024;
constexpr size_t O_STATE = O_ONSA + (size_t)48 * 1024 * 1024;
constexpr size_t O_CSH = O_B1P + 65536;
constexpr size_t O_ACT = O_QN;
static_assert(O_ACT + (size_t)TT * 4096 * 2 <= O_END, "act overlay");
static_assert(O_END <= (size_t)536870912, "ws budget");

struct Args {
  const float* in[16];
  float* out;
  unsigned char* ws;
  int ph_lo, ph_hi;
};

DI int get_tid() { int t = threadIdx.x; asm volatile("" : "+v"(t)); return t; }
typedef __bf16 bf16v2 __attribute__((ext_vector_type(2)));
typedef float f32v2 __attribute__((ext_vector_type(2)));
DI bfu f2bf(float x) { return __builtin_bit_cast(bfu, (__bf16)x); }
DI float bf2f(bfu v) { return __uint_as_float(((unsigned)v) << 16); }
DI unsigned pack2(float a, float b) { f32v2 v = {a, b}; return __builtin_bit_cast(unsigned, __builtin_convertvector(v, bf16v2)); }
DI void store4bf(bfu* dst, float a, float b, float c, float d) {
  uint2 v; v.x = pack2(a, b); v.y = pack2(c, d);
  *reinterpret_cast<uint2*>(dst) = v;
}
DI void store_pair16(bfu* rowp, int g, uint2 c0, uint2 c1) {
  const bool odd = (g & 1) != 0;
  const uint2 send = odd ? c0 : c1;
  uint2 recv; recv.x = __shfl_xor(send.x, 16); recv.y = __shfl_xor(send.y, 16);
  uint4 o;
  if (!odd) { o.x = c0.x; o.y = c0.y; o.z = recv.x; o.w = recv.y; }
  else { o.x = recv.x; o.y = recv.y; o.z = c1.x; o.w = c1.y; }
  *reinterpret_cast<uint4*>(rowp + (odd ? (12 + 4 * g) : (4 * g))) = o;
}
DI uint2 pack4(float a, float b, float c, float d) { uint2 v; v.x = pack2(a, b); v.y = pack2(c, d); return v; }
DI float fmax_fast(float a, float b) { float r; asm("v_max_f32 %0, %1, %2" : "=v"(r) : "v"(a), "v"(b)); return r; }
DI float fmax3_fast(float a, float b, float c) { float r; asm("v_max3_f32 %0, %1, %2, %3" : "=v"(r) : "v"(a), "v"(b), "v"(c)); return r; }
DI float wave_sum(float v) {
#pragma unroll
  for (int o = 32; o >= 1; o >>= 1) v += __shfl_xor(v, o);
  return v;
}
DI float siluf(float x) { return x * __builtin_amdgcn_rcpf(1.f + __expf(-x)); }
DI float sigmf(float x) { return __builtin_amdgcn_rcpf(1.f + __expf(-x)); }
DI float ret_log2gamma(int h) { return log2f(1.f - exp2f(-5.f - (float)h)); }

constexpr int LSTR = 64;
constexpr int RSTR_K = 72;
DI int swz(int row, int chunk) { return row * 64 + ((chunk ^ ((row >> 1) & 7)) << 3); }
constexpr int LTILE = 128 * LSTR;
constexpr int SMEM_BYTES = 100352 + 32768;

struct ARowPlain {
  const bfu* base; size_t ld;
  DI const bfu* operator()(int r) const { return base + (size_t)r * ld; }
};
struct ARowCmp {
  const bfu* base;
  DI const bfu* operator()(int r) const { int bg = r >> 7, c = r & 127; c = c > 126 ? 126 : c; return base + ((size_t)bg * 2048 + (size_t)c * 16) * 64; }
};

struct BRowClamp64 {
  const bfu* base; size_t ld;
  DI const bfu* operator()(int r) const { return base + (size_t)(r & 63) * ld; }
};
struct ARowClamp128 {
  const bfu* base; size_t ld;
  DI const bfu* operator()(int r) const { return base + (size_t)(r & 127) * ld; }
};
DI uint4 a_f32_bias_silu(const bfu* p, const float* bias) {
  float4 x0 = *reinterpret_cast<const float4*>(p), x1 = *reinterpret_cast<const float4*>(p + 8);
#pragma unroll
  for (int ks = 1; ks < 4; ++ks) {
    const bfu* q = p + (size_t)ks * 2 * 4096 * 256 * 2;
    const float4 y0 = *reinterpret_cast<const float4*>(q), y1 = *reinterpret_cast<const float4*>(q + 8);
    x0.x += y0.x; x0.y += y0.y; x0.z += y0.z; x0.w += y0.w; x1.x += y1.x; x1.y += y1.y; x1.z += y1.z; x1.w += y1.w;
  }
  const float4 b0 = *reinterpret_cast<const float4*>(bias), b1 = *reinterpret_cast<const float4*>(bias + 4);
  uint4 r;
  r.x = pack2(siluf(x0.x + b0.x), siluf(x0.y + b0.y)); r.y = pack2(siluf(x0.z + b0.z), siluf(x0.w + b0.w));
  r.z = pack2(siluf(x1.x + b1.x), siluf(x1.y + b1.y)); r.w = pack2(siluf(x1.z + b1.z), siluf(x1.w + b1.w));
  return r;
}
template <int MT, int AMODE = 0, class ARow, class BRow, class Epi>
DI void gemm_tile(const ARow& arow, const BRow& brow, int K, int m0, int n0, Epi& epi, bfu* smem, const float* abias = nullptr) {
  constexpr int BN = (MT == 4) ? 128 : 256;
  constexpr int NBL = BN / 64;
  constexpr int STAGE = (256 + BN) * LSTR;
  const int tid = get_tid(), lane = tid & 63, wid = __builtin_amdgcn_readfirstlane(tid >> 6);
  const int wr = (MT == 4) ? (wid >> 1) : (wid >> 2), wc = (MT == 4) ? (wid & 1) : (wid & 3);
  const int arow0 = wr * (16 * MT), bcol0 = wc * 64;
  const int c = lane & 15, g = lane >> 4;
  const int lrow = tid >> 3, lcc = tid & 7;
  const int lsw = swz(lrow, lcc);
  const int rsw0 = ((g ^ (c >> 1)) << 3), rsw1 = (((4 + g) ^ (c >> 1)) << 3);
  const bfu* ap[4]; const bfu* bp[NBL];
#pragma unroll
  for (int i = 0; i < 4; ++i) ap[i] = arow(m0 + lrow + 64 * i) + lcc * 8 * (AMODE ? 2 : 1);
  const float* abp = abias + lcc * 8;
#pragma unroll
  for (int i = 0; i < NBL; ++i) bp[i] = brow(n0 + lrow + 64 * i) + lcc * 8;
  f32x4 acc[MT / 4][4][4];
#pragma unroll
  for (int h = 0; h < MT / 4; ++h)
#pragma unroll
    for (int m = 0; m < 4; ++m)
#pragma unroll
      for (int n = 0; n < 4; ++n) acc[h][m][n] = f32x4{0.f, 0.f, 0.f, 0.f};
  uint4 ra0, ra1, ra2, ra3, rb0, rb1, rb2, rb3;
  const int nk = K / 64;
#define G_LOAD(KO) { if (AMODE == 0) { ra0 = *reinterpret_cast<const uint4*>(ap[0] + (KO)); ra1 = *reinterpret_cast<const uint4*>(ap[1] + (KO)); \
    ra2 = *reinterpret_cast<const uint4*>(ap[2] + (KO)); ra3 = *reinterpret_cast<const uint4*>(ap[3] + (KO)); } else { \
    ra0 = a_f32_bias_silu(ap[0] + 2 * (KO), abp + (KO)); ra1 = a_f32_bias_silu(ap[1] + 2 * (KO), abp + (KO)); \
    ra2 = a_f32_bias_silu(ap[2] + 2 * (KO), abp + (KO)); ra3 = a_f32_bias_silu(ap[3] + 2 * (KO), abp + (KO)); } \
    rb0 = *reinterpret_cast<const uint4*>(bp[0] + (KO)); rb1 = *reinterpret_cast<const uint4*>(bp[1] + (KO)); \
    if (NBL == 4) { rb2 = *reinterpret_cast<const uint4*>(bp[NBL - 2] + (KO)); rb3 = *reinterpret_cast<const uint4*>(bp[NBL - 1] + (KO)); } }
#define G_STORE(SA, SB) { *reinterpret_cast<uint4*>((SA) + lsw) = ra0; *reinterpret_cast<uint4*>((SA) + lsw + 64 * LSTR) = ra1; \
    *reinterpret_cast<uint4*>((SA) + lsw + 128 * LSTR) = ra2; *reinterpret_cast<uint4*>((SA) + lsw + 192 * LSTR) = ra3; \
    *reinterpret_cast<uint4*>((SB) + lsw) = rb0; *reinterpret_cast<uint4*>((SB) + lsw + 64 * LSTR) = rb1; \
    if (NBL == 4) { *reinterpret_cast<uint4*>((SB) + lsw + 128 * LSTR) = rb2; *reinterpret_cast<uint4*>((SB) + lsw + 192 * LSTR) = rb3; } }
  G_LOAD(0)
  G_STORE(smem, smem + 256 * LSTR)
  __syncthreads();
  for (int kt = 0; kt < nk; ++kt) {
    const int cur = kt & 1;
    if (kt + 1 < nk) G_LOAD((kt + 1) * 64)
    __builtin_amdgcn_sched_barrier(0);
    const bfu* sA = smem + cur * STAGE;
    const bfu* sB = sA + 256 * LSTR;
#pragma unroll
    for (int ks = 0; ks < 2; ++ks) {
      bf16x8 af[MT], bfr[4];
#pragma unroll
      for (int m = 0; m < MT; ++m) af[m] = *reinterpret_cast<const bf16x8*>(sA + (arow0 + 16 * m + c) * LSTR + (ks ? rsw1 : rsw0));
#pragma unroll
      for (int n = 0; n < 4; ++n) bfr[n] = *reinterpret_cast<const bf16x8*>(sB + (bcol0 + 16 * n + c) * LSTR + (ks ? rsw1 : rsw0));
#pragma unroll
      for (int m = 0; m < MT; ++m)
#pragma unroll
        for (int n = 0; n < 4; ++n) acc[m >> 2][m & 3][n] = __builtin_amdgcn_mfma_f32_16x16x32_bf16(bfr[n], af[m], acc[m >> 2][m & 3][n], 0, 0, 0);
    }
    __builtin_amdgcn_sched_barrier(0);
    if (kt + 1 < nk) { bfu* dA = smem + (cur ^ 1) * STAGE; G_STORE(dA, dA + 256 * LSTR) }
    __syncthreads();
  }
#undef G_LOAD
#undef G_STORE
#pragma unroll
  for (int h = 0; h < MT / 4; ++h) epi(m0 + arow0 + 64 * h, n0 + bcol0, acc[h]);
}

constexpr int G8_BK = 64, G8_HALF = 128, G8_HT = G8_HALF * G8_BK;
DI int g8_lds_byte(int r, int c) {
  int st = (r >> 4) * 2 + (c >> 5), rr = r & 15, cc = c & 31, ob = rr * 64 + cc * 2;
  return st * 1024 + (ob ^ (((ob >> 9) & 1) << 5));
}
DI void g8_stage_rc(int b, int& R, int& C) {
  int st = b / 1024, sb = b % 1024, swz_ = sb ^ (((sb >> 9) & 1) << 5);
  R = (st >> 1) * 16 + swz_ / 64; C = (st & 1) * 32 + (swz_ % 64) / 2;
}
template <int HEADS = 0, class Epi>
DI void gemm8p_tile(const bfu* __restrict__ A, const bfu* __restrict__ Bt, int K, int brow, int bcol, Epi& epi) {
  extern __shared__ __attribute__((aligned(16))) bfu g8shm[];
#define G8_SA(b, h) (g8shm + ((b) * 2 + (h)) * G8_HT)
#define G8_SB(b, h) (g8shm + (4 + (b) * 2 + (h)) * G8_HT)
#define G8_STAGE(P, BASE, br, kt) do { const char* _ub = (const char*)(BASE) + 2 * ((long)(br) * K + (long)(kt) * G8_BK); \
      __builtin_amdgcn_global_load_lds((const unsigned*)(_ub + voff0), \
        (__attribute__((address_space(3))) unsigned*)((__attribute__((address_space(3))) char*)(P) + tb16), 16, 0, 0); \
      __builtin_amdgcn_global_load_lds((const unsigned*)(_ub + voff1), \
        (__attribute__((address_space(3))) unsigned*)((__attribute__((address_space(3))) char*)(P) + tb16 + 8192), 16, 0, 0); } while (0)
#define G8_LDA(dst, b, h) for (int m = 0; m < 4; ++m) for (int k = 0; k < 2; ++k) \
    dst[m][k] = *reinterpret_cast<const bf16x8*>((const char*)G8_SA(b, h) + g8_lds_byte(wr * 64 + m * 16 + fr, k * 32 + fq * 8))
#define G8_LDB(dst, b, h) for (int n = 0; n < 2; ++n) for (int k = 0; k < 2; ++k) \
    dst[n][k] = *reinterpret_cast<const bf16x8*>((const char*)G8_SB(b, h) + g8_lds_byte(wc * 32 + n * 16 + fr, k * 32 + fq * 8))
#define G8_MMA(ai, bj, At_, Bt_) do { __builtin_amdgcn_s_setprio(1); \
    for (int m = 0; m < 4; ++m) for (int n = 0; n < 2; ++n) for (int k = 0; k < 2; ++k) \
      acc[ai][bj][m][n] = __builtin_amdgcn_mfma_f32_16x16x32_bf16(Bt_[n][k], At_[m][k], acc[ai][bj][m][n], 0, 0, 0); \
    __builtin_amdgcn_s_setprio(0); } while (0)
#define G8_WAIT_V(n) asm volatile("s_waitcnt vmcnt(" #n ")" ::: "memory")
#define G8_WAIT_L(n) asm volatile("s_waitcnt lgkmcnt(" #n ")" ::: "memory")
#define G8_BAR __builtin_amdgcn_s_barrier()
#define G8_SCHED __builtin_amdgcn_sched_barrier(0)
  const int tid8 = get_tid();
  const int wid = __builtin_amdgcn_readfirstlane(tid8 >> 6), lane = tid8 & 63, wr = wid >> 2, wc = wid & 3, fr = lane & 15, fq = lane >> 4;
  const int tb16 = tid8 * 16;
  unsigned voff0, voff1;
  { int r_, c_; g8_stage_rc(tb16, r_, c_); voff0 = 2u * ((unsigned)r_ * (unsigned)K + (unsigned)c_);
    g8_stage_rc(tb16 + 8192, r_, c_); voff1 = 2u * ((unsigned)r_ * (unsigned)K + (unsigned)c_); }
  f32x4 acc[2][2][4][2];
#pragma unroll
  for (int a_ = 0; a_ < 2; ++a_)
#pragma unroll
    for (int b_ = 0; b_ < 2; ++b_)
#pragma unroll
      for (int m = 0; m < 4; ++m)
#pragma unroll
        for (int n = 0; n < 2; ++n) acc[a_][b_][m][n] = f32x4{0.f, 0.f, 0.f, 0.f};
  bf16x8 At[4][2], B0[2][2], B1[2][2];
  const int nt = K / G8_BK;
  G8_WAIT_V(0);
  if (HEADS) { G8_WAIT_L(0); G8_BAR; }
  G8_STAGE(G8_SB(0, 0), Bt, bcol, 0); G8_STAGE(G8_SA(0, 0), A, brow, 0);
  G8_STAGE(G8_SB(0, 1), Bt, bcol + G8_HALF, 0); G8_STAGE(G8_SA(0, 1), A, brow + G8_HALF, 0);
  if (wr == 1) G8_BAR;
  G8_WAIT_V(4); G8_BAR;
  G8_STAGE(G8_SB(1, 0), Bt, bcol, 1); G8_STAGE(G8_SA(1, 0), A, brow, 1); G8_STAGE(G8_SB(1, 1), Bt, bcol + G8_HALF, 1);
  G8_WAIT_V(6); G8_BAR;
  for (int t = 0; t < nt - 2; t += 2) {
    G8_LDB(B0, 0, 0); G8_SCHED; G8_LDA(At, 0, 0); G8_STAGE(G8_SA(1, 1), A, brow + G8_HALF, t + 1);
    G8_WAIT_L(8); G8_BAR; G8_WAIT_L(0); G8_MMA(0, 0, At, B0); G8_BAR; G8_SCHED;
    G8_LDB(B1, 0, 1); G8_STAGE(G8_SB(0, 0), Bt, bcol, t + 2);
    G8_BAR; G8_WAIT_L(0); G8_MMA(0, 1, At, B1); G8_BAR;
    G8_LDA(At, 0, 1); G8_STAGE(G8_SA(0, 0), A, brow, t + 2);
    G8_BAR; G8_WAIT_L(0); G8_MMA(1, 0, At, B0); G8_BAR; G8_SCHED;
    G8_STAGE(G8_SB(0, 1), Bt, bcol + G8_HALF, t + 2);
    G8_WAIT_V(6); G8_BAR; G8_MMA(1, 1, At, B1); G8_BAR;
    G8_LDB(B0, 1, 0); G8_SCHED; G8_LDA(At, 1, 0); G8_STAGE(G8_SA(0, 1), A, brow + G8_HALF, t + 2);
    G8_WAIT_L(8); G8_BAR; G8_WAIT_L(0); G8_MMA(0, 0, At, B0); G8_BAR; G8_SCHED;
    G8_LDB(B1, 1, 1); G8_STAGE(G8_SB(1, 0), Bt, bcol, t + 3);
    G8_BAR; G8_WAIT_L(0); G8_MMA(0, 1, At, B1); G8_BAR;
    G8_LDA(At, 1, 1); G8_STAGE(G8_SA(1, 0), A, brow, t + 3);
    G8_BAR; G8_WAIT_L(0); G8_MMA(1, 0, At, B0); G8_BAR; G8_SCHED;
    G8_STAGE(G8_SB(1, 1), Bt, bcol + G8_HALF, t + 3);
    G8_WAIT_V(6); G8_BAR; G8_MMA(1, 1, At, B1); G8_BAR;
  }
  epi.pre(brow + wr * 64);
  { G8_LDB(B0, 0, 0); G8_LDA(At, 0, 0); G8_STAGE(G8_SA(1, 1), A, brow + G8_HALF, nt - 1);
    G8_BAR; G8_WAIT_L(0); G8_MMA(0, 0, At, B0); G8_BAR;
    G8_LDB(B1, 0, 1); G8_BAR; G8_WAIT_L(0); G8_MMA(0, 1, At, B1); G8_BAR;
    G8_LDA(At, 0, 1); G8_WAIT_V(4); G8_BAR; G8_WAIT_L(0); G8_MMA(1, 0, At, B0); G8_MMA(1, 1, At, B1); G8_BAR; }
  { G8_LDB(B0, 1, 0); G8_LDA(At, 1, 0); G8_WAIT_V(2); G8_BAR; G8_WAIT_L(0); G8_MMA(0, 0, At, B0); G8_BAR;
    G8_LDB(B1, 1, 1); G8_WAIT_V(0); G8_BAR; G8_WAIT_L(0); G8_MMA(0, 1, At, B1); G8_BAR;
    G8_LDA(At, 1, 1); G8_BAR; G8_WAIT_L(0); G8_MMA(1, 0, At, B0); G8_MMA(1, 1, At, B1); G8_BAR; }
  if (wr == 0) G8_BAR;
  if constexpr (HEADS != 0) {
    f32x4* park = reinterpret_cast<f32x4*>(g8shm) + (size_t)wid * 1024 + lane;
#pragma unroll
    for (int m = 0; m < 4; ++m) { park[(4 * m + 0) * 64] = acc[1][0][m][0]; park[(4 * m + 1) * 64] = acc[1][0][m][1]; park[(4 * m + 2) * 64] = acc[1][1][m][0]; park[(4 * m + 3) * 64] = acc[1][1][m][1]; }
    {
      f32x4 hacc[4][4];
#pragma unroll
      for (int m = 0; m < 4; ++m) { hacc[m][0] = acc[0][0][m][0]; hacc[m][1] = acc[0][0][m][1]; hacc[m][2] = acc[0][1][m][0]; hacc[m][3] = acc[0][1][m][1]; }
      epi(brow + wr * 64, bcol + wc * 64, hacc);
    }
    __builtin_amdgcn_sched_barrier(0);
    {
      f32x4 hacc[4][4];
#pragma unroll
      for (int m = 0; m < 4; ++m)
#pragma unroll
        for (int n = 0; n < 4; ++n) hacc[m][n] = park[(4 * m + n) * 64];
      epi(brow + G8_HALF + wr * 64, bcol + wc * 64, hacc);
    }
  } else {
#pragma unroll
    for (int ai = 0; ai < 2; ++ai)
#pragma unroll
      for (int bj = 0; bj < 2; ++bj) epi(brow + ai * G8_HALF + wr * 64, bcol + bj * G8_HALF + wc * 32, acc[ai][bj]);
  }
#undef G8_SA
#undef G8_SB
#undef G8_STAGE
#undef G8_LDA
#undef G8_LDB
#undef G8_MMA
#undef G8_WAIT_V
#undef G8_WAIT_L
#undef G8_BAR
#undef G8_SCHED
}

struct EpiProj {
  unsigned char* ws; const float* qnw; const float* knw;
  DI void pre(int) {}
  DI void operator()(int row0, int col0, f32x4 (&acc)[4][4]) const {
    const int lane = get_tid() & 63, c = lane & 15, g = lane >> 4;
    const int b = row0 >> 11, s0 = row0 & 2047;
    if (col0 >= 2880) return;
    if (col0 == 2816) {
      float* dst = reinterpret_cast<float*>(ws + O_GT);
#pragma unroll
      for (int m = 0; m < 4; ++m) {
        const size_t t = (size_t)row0 + 16 * m + c;
#pragma unroll
        for (int n = 0; n < 2; ++n) {
          const int f = 16 * n + 4 * g;
          if (f < 24) {
            float4 v; v.x = sigmf(acc[m][n][0]); v.y = sigmf(acc[m][n][1]); v.z = sigmf(acc[m][n][2]); v.w = sigmf(acc[m][n][3]);
            *reinterpret_cast<float4*>(dst + t * 24 + f) = v;
          }
        }
      }
      return;
    }
    int seg, hh;
    if (col0 < 512) { seg = 0; hh = col0 >> 6; }
    else if (col0 < 1280) { seg = 1 + ((col0 - 512) >> 7); hh = ((col0 - 512) & 127) >> 6; }
    else if (col0 < 1536) { seg = 7; hh = (col0 - 1280) >> 6; }
    else if (col0 < 1792) { seg = 8; hh = (col0 - 1536) >> 6; }
    else if (col0 < 2304) { seg = 9; hh = (col0 - 1792) >> 7; }
    else { seg = 10; hh = 0; }
    const bool do_norm = (seg == 0 || seg == 1 || seg == 3 || seg == 5);
    const bool do_rope = do_norm || seg == 7 || seg == 8;
    bfu* dstA = nullptr; size_t strideA = 64;
    bfu* dstA2 = nullptr;
    bfu* dstB = nullptr;
    const size_t bg64 = ((size_t)(b * 2 + hh) * 2048) * 64;
    const size_t bh64 = ((size_t)(b * 4 + hh) * 2048) * 64;
    if (seg == 0) dstA = reinterpret_cast<bfu*>(ws + O_QN) + ((size_t)(b * 8 + hh) * 2048 + s0) * 64;
    else if (seg == 1) dstA = reinterpret_cast<bfu*>(ws + O_KC) + bg64 + (size_t)s0 * 64;
    else if (seg == 2) dstA = reinterpret_cast<bfu*>(ws + O_VC) + bg64 + (size_t)s0 * 64;
    else if (seg == 3) dstA = reinterpret_cast<bfu*>(ws + O_KS) + bg64 + (size_t)s0 * 64;
    else if (seg == 4) dstB = reinterpret_cast<bfu*>(ws + O_VST) + bg64 + s0;
    else if (seg == 5) dstA = reinterpret_cast<bfu*>(ws + O_KW) + bg64 + (size_t)s0 * 64;
    else if (seg == 6) dstB = reinterpret_cast<bfu*>(ws + O_VWT) + bg64 + s0;
    else if (seg == 7) { dstA = reinterpret_cast<bfu*>(ws + O_RQ) + bh64 + (size_t)s0 * 64; dstA2 = reinterpret_cast<bfu*>(ws + O_RQX) + bh64 + (size_t)s0 * 64; }
    else if (seg == 8) { dstA = reinterpret_cast<bfu*>(ws + O_RK) + bh64 + (size_t)s0 * 64; dstB = reinterpret_cast<bfu*>(ws + O_RKTZ) + bh64 + s0; }
    else if (seg == 9) dstB = reinterpret_cast<bfu*>(ws + O_RVT) + ((size_t)(b * 4 + hh) * 128 + ((col0 - 1792) & 127)) * 2048 + s0;
    else { dstA = reinterpret_cast<bfu*>(ws + O_RG) + (size_t)row0 * 512 + (col0 - 2304); strideA = 512; }

    if (do_norm) {
      const float* nw = (seg == 0) ? qnw : (knw + ((seg - 1) >> 1) * 64);
#pragma unroll
      for (int m = 0; m < 4; ++m) {
        float ss = 0.f;
#pragma unroll
        for (int n = 0; n < 4; ++n)
#pragma unroll
          for (int j = 0; j < 4; ++j) ss += acc[m][n][j] * acc[m][n][j];
        ss += __shfl_xor(ss, 16); ss += __shfl_xor(ss, 32);
        const float r = rsqrtf(ss * (1.f / 64.f) + EPSF);
#pragma unroll
        for (int n = 0; n < 4; ++n) {
          const float4 w = *reinterpret_cast<const float4*>(nw + 16 * n + 4 * g);
          acc[m][n][0] *= r * w.x; acc[m][n][1] *= r * w.y; acc[m][n][2] *= r * w.z; acc[m][n][3] *= r * w.w;
        }
        __builtin_amdgcn_sched_barrier(0);
      }
    }
    if (do_rope) {
      const float* ropeC = reinterpret_cast<const float*>(ws + O_ROPEC);
      const float* ropeS = reinterpret_cast<const float*>(ws + O_ROPES);
      const float mul = (seg == 0) ? 0.125f * LOG2E_C : ((seg == 8) ? 0.125f : 1.f);
#pragma unroll
      for (int m = 0; m < 4; ++m) {
        const int s = s0 + 16 * m + c;
#pragma unroll
        for (int n = 0; n < 2; ++n) {
          const unsigned ro = (unsigned)(s * 32 + 16 * n + 4 * g);
          float4 cs = *reinterpret_cast<const float4*>(ropeC + ro);
          float4 sn = *reinterpret_cast<const float4*>(ropeS + ro);
          cs.x *= mul; cs.y *= mul; cs.z *= mul; cs.w *= mul; sn.x *= mul; sn.y *= mul; sn.z *= mul; sn.w *= mul;
          float x1, x2;
          x1 = acc[m][n][0]; x2 = acc[m][n + 2][0]; acc[m][n][0] = x1 * cs.x - x2 * sn.x; acc[m][n + 2][0] = x2 * cs.x + x1 * sn.x;
          x1 = acc[m][n][1]; x2 = acc[m][n + 2][1]; acc[m][n][1] = x1 * cs.y - x2 * sn.y; acc[m][n + 2][1] = x2 * cs.y + x1 * sn.y;
          x1 = acc[m][n][2]; x2 = acc[m][n + 2][2]; acc[m][n][2] = x1 * cs.z - x2 * sn.z; acc[m][n + 2][2] = x2 * cs.z + x1 * sn.z;
          x1 = acc[m][n][3]; x2 = acc[m][n + 2][3]; acc[m][n][3] = x1 * cs.w - x2 * sn.w; acc[m][n + 2][3] = x2 * cs.w + x1 * sn.w;
        }
        __builtin_amdgcn_sched_barrier(0);
      }
    }
    if (seg == 10) {
#pragma unroll
      for (int m = 0; m < 4; ++m)
#pragma unroll
        for (int n = 0; n < 4; ++n)
#pragma unroll
          for (int j = 0; j < 4; ++j) acc[m][n][j] = siluf(acc[m][n][j]);
    }
    if (dstA) {
#pragma unroll
      for (int m = 0; m < 4; ++m) {
        bfu* d = dstA + (size_t)(16 * m + c) * strideA;
        store_pair16(d, g, pack4(acc[m][0][0], acc[m][0][1], acc[m][0][2], acc[m][0][3]), pack4(acc[m][1][0], acc[m][1][1], acc[m][1][2], acc[m][1][3]));
        store_pair16(d + 32, g, pack4(acc[m][2][0], acc[m][2][1], acc[m][2][2], acc[m][2][3]), pack4(acc[m][3][0], acc[m][3][1], acc[m][3][2], acc[m][3][3]));
        __builtin_amdgcn_sched_barrier(0);
      }
    }
    if (seg == 7 || seg == 8) {
      const float l2g = ret_log2gamma(hh);
#pragma unroll
      for (int m = 0; m < 4; ++m) {
        const int i = (s0 + 16 * m + c) & 127;
        const float f = exp2f(l2g * (float)((seg == 7) ? (i + 1) : (127 - i)));
#pragma unroll
        for (int n = 0; n < 4; ++n)
#pragma unroll
          for (int j = 0; j < 4; ++j) acc[m][n][j] *= f;
      }
    }
    if (dstA2) {
#pragma unroll
      for (int m = 0; m < 4; ++m) {
        bfu* d = dstA2 + (size_t)(16 * m + c) * 64;
        store_pair16(d, g, pack4(acc[m][0][0], acc[m][0][1], acc[m][0][2], acc[m][0][3]), pack4(acc[m][1][0], acc[m][1][1], acc[m][1][2], acc[m][1][3]));
        store_pair16(d + 32, g, pack4(acc[m][2][0], acc[m][2][1], acc[m][2][2], acc[m][2][3]), pack4(acc[m][3][0], acc[m][3][1], acc[m][3][2], acc[m][3][3]));
        __builtin_amdgcn_sched_barrier(0);
      }
    }
    if (dstB) {
#pragma unroll
      for (int m = 0; m < 4; ++m) {
        bfu* d = dstB + (size_t)(4 * g) * 2048 + 16 * m + c;
#pragma unroll
        for (int n = 0; n < 4; ++n)
#pragma unroll
          for (int j = 0; j < 4; ++j) d[(size_t)(16 * n + j) * 2048] = f2bf(acc[m][n][j]);
        __builtin_amdgcn_sched_barrier(0);
      }
    }
  }
};

struct EpiCmp1 {
  float* H;
  DI void operator()(int row0, int col0, f32x4 (&acc)[4][4]) const {
    const int lane = get_tid() & 63, c = lane & 15, g = lane >> 4;
#pragma unroll
    for (int m = 0; m < 4; ++m) {
      float* hr = H + ((size_t)row0 + 16 * m + c) * 256 + col0 + 4 * g;
#pragma unroll
      for (int n = 0; n < 4; ++n) {
        float4 v; v.x = acc[m][n][0]; v.y = acc[m][n][1]; v.z = acc[m][n][2]; v.w = acc[m][n][3];
        *reinterpret_cast<float4*>(hr + 16 * n) = v;
      }
    }
  }
};

struct EpiCmp2 {
  bfu* dst; int kv;
  DI void operator()(int row0, int col0, f32x4 (&acc)[4][4]) const {
    if (col0 != 0) return;
    const int lane = get_tid() & 63, c = lane & 15, g = lane >> 4;
#pragma unroll
    for (int m = 0; m < 4; ++m) {
      const int r = row0 + 16 * m + c, bg = r >> 7, ci = r & 127;
      const float z = (ci == 127) ? 0.f : 1.f;
#pragma unroll
      for (int n = 0; n < 4; ++n) {
        const int d = 16 * n + 4 * g;
        if (kv == 0) store4bf(dst + ((size_t)bg * 128 + ci) * 64 + d, acc[m][n][0] * z, acc[m][n][1] * z, acc[m][n][2] * z, acc[m][n][3] * z);
        else {
#pragma unroll
          for (int j = 0; j < 4; ++j) dst[((size_t)bg * 64 + d + j) * 128 + ci] = f2bf(acc[m][n][j] * z);
        }
      }
    }
  }
};

struct EpiOut {
  const float* x; float* out;
  DI void operator()(int row0, int col0, f32x4 (&acc)[4][4]) const {
    const int lane = get_tid() & 63, c = lane & 15, g = lane >> 4;
#pragma unroll
    for (int m = 0; m < 4; ++m) {
      const size_t t = (size_t)row0 + 16 * m + c;
#pragma unroll
      for (int n = 0; n < 4; ++n) {
        const size_t o = t * 1024 + col0 + 16 * n + 4 * g;
        float4 xv = *reinterpret_cast<const float4*>(x + o);
        xv.x += acc[m][n][0]; xv.y += acc[m][n][1]; xv.z += acc[m][n][2]; xv.w += acc[m][n][3];
        *reinterpret_cast<float4*>(out + o) = xv;
      }
    }
  }
};

struct EpiUp {
  bfu* act;
  DI void operator()(int row0, int col0, f32x4 (&acc)[4][4]) const {
    const int lane = get_tid() & 63, c = lane & 15, g = lane >> 4;
#pragma unroll
    for (int m = 0; m < 4; ++m) {
      const size_t t = (size_t)row0 + 16 * m + c;
#pragma unroll
      for (int n = 0; n < 4; ++n) {
        float v[4];
#pragma unroll
        for (int j = 0; j < 4; ++j) { const float r = fmaxf(acc[m][n][j], 0.f); v[j] = r * r; }
        store4bf(act + t * 4096 + col0 + 16 * n + 4 * g, v[0], v[1], v[2], v[3]);
      }
    }
  }
};

struct EpiDown {
  float* out;
  DI void operator()(int row0, int col0, f32x4 (&acc)[4][4]) const {
    const int lane = get_tid() & 63, c = lane & 15, g = lane >> 4;
#pragma unroll
    for (int m = 0; m < 4; ++m) {
      const size_t t = (size_t)row0 + 16 * m + c;
#pragma unroll
      for (int n = 0; n < 4; ++n) {
        float* o = out + t * 1024 + col0 + 16 * n + 4 * g;
        float4 xv = *reinterpret_cast<const float4*>(o);
        xv.x += acc[m][n][0]; xv.y += acc[m][n][1]; xv.z += acc[m][n][2]; xv.w += acc[m][n][3];
        *reinterpret_cast<float4*>(o) = xv;
      }
    }
  }
};


struct EpiOut2 {
  const float* x; float* out; bfu* hb; float* ss2;
  float pend[4];
  DI void pre(int) {}
  DI void operator()(int row0, int col0, f32x4 (&acc)[4][2]) {
    const int lane = get_tid() & 63, c = lane & 15, g = lane >> 4;
    const bool second = ((col0 >> 7) & 1) != 0;
#pragma unroll
    for (int m = 0; m < 4; ++m) {
      const size_t t = (size_t)row0 + 16 * m + c;
      float ss = 0.f;
      uint2 hch[2];
#pragma unroll
      for (int n = 0; n < 2; ++n) {
        const size_t o = t * 1024 + col0 + 16 * n + 4 * g;
        float4 xv = *reinterpret_cast<const float4*>(x + o);
        xv.x += acc[m][n][0]; xv.y += acc[m][n][1]; xv.z += acc[m][n][2]; xv.w += acc[m][n][3];
        hch[n] = pack4(xv.x, xv.y, xv.z, xv.w);
        ss += xv.x * xv.x + xv.y * xv.y + xv.z * xv.z + xv.w * xv.w;
      }
      store_pair16(hb + t * 1024 + col0, g, hch[0], hch[1]);
      if (!second) pend[m] = ss;
      else {
        ss += pend[m];
        ss += __shfl_xor(ss, 16); ss += __shfl_xor(ss, 32);
        if (g == 0) unsafeAtomicAdd(ss2 + t, ss);
      }
    }
  }
};
struct EpiUp2 {
  bfu* act; const float* ss2;
  float ssv[2][4]; int base;
  DI void pre(int row0a) {
    const int c = get_tid() & 15;
    base = row0a;
#pragma unroll
    for (int ai = 0; ai < 2; ++ai)
#pragma unroll
      for (int m = 0; m < 4; ++m) ssv[ai][m] = ss2[(size_t)row0a + 128 * ai + 16 * m + c];
  }
  DI void operator()(int row0, int col0, f32x4 (&acc)[4][2]) const {
    const int lane = get_tid() & 63, c = lane & 15, g = lane >> 4;
    const bool hi = (row0 != base);
#pragma unroll
    for (int m = 0; m < 4; ++m) {
      const size_t t = (size_t)row0 + 16 * m + c;
      const float r2 = rsqrtf((hi ? ssv[1][m] : ssv[0][m]) * (1.f / 1024.f) + EPSF);
      uint2 ch[2];
#pragma unroll
      for (int n = 0; n < 2; ++n) {
        float v[4];
#pragma unroll
        for (int j = 0; j < 4; ++j) { const float r = fmaxf(acc[m][n][j] * r2, 0.f); v[j] = r * r; }
        ch[n] = pack4(v[0], v[1], v[2], v[3]);
      }
      store_pair16(act + t * 4096 + col0, g, ch[0], ch[1]);
    }
  }
};
struct EpiDown2 {
  float* out; const bfu* hb;
  DI void pre(int) {}
  DI void operator()(int row0, int col0, f32x4 (&acc)[4][2]) const {
    const int lane = get_tid() & 63, c = lane & 15, g = lane >> 4;
#pragma unroll
    for (int m = 0; m < 4; ++m) {
      const size_t t = (size_t)row0 + 16 * m + c;
#pragma unroll
      for (int n = 0; n < 2; ++n) {
        const size_t o = t * 1024 + col0 + 16 * n + 4 * g;
        const uint2 hv = *reinterpret_cast<const uint2*>(hb + o);
        float4 xv;
        xv.x = __uint_as_float(hv.x << 16) + acc[m][n][0]; xv.y = __uint_as_float(hv.x & 0xffff0000u) + acc[m][n][1];
        xv.z = __uint_as_float(hv.y << 16) + acc[m][n][2]; xv.w = __uint_as_float(hv.y & 0xffff0000u) + acc[m][n][3];
        *reinterpret_cast<float4*>(out + o) = xv;
      }
    }
  }
};

DI bool tile_map(int it, int nM, int nN, int& pm, int& pn) {
  const int nwg = nM * nN, xcd = blockIdx.x & 7, slot = blockIdx.x >> 3, per = gridDim.x >> 3;
  const int q = nwg >> 3;
  const int loc = it * per + slot;
  if (slot >= per || loc >= q) return false;
  const int id = xcd * q + loc;
  const int nig = 8 * nN, gid = id / nig, fm = gid * 8;
  const int gsz = (nM - fm < 8) ? (nM - fm) : 8;
  pm = fm + (id % nig) % gsz; pn = (id % nig) / gsz;
  return true;
}

DI int win_src_col(int n) {
  if (n < 1280) return n;
  if (n < 2816) return n + 24;
  if (n < 2840) return n - 2816 + 1280;
  return -1;
}
DI void tconv(const float* __restrict__ src, int K, int N, bfu* __restrict__ dst, int Np, int mode, float* tl, const float* kscale = nullptr) {
  const int tid = get_tid(), tx = tid & 63, ty = tid >> 6;
  const int ntk = K / 64, ntn = Np / 64, ntile = ntk * ntn;
  float v[8];
  auto load_tile = [&](int tile) {
    const int k0 = (tile % ntk) * 64, n0 = (tile / ntk) * 64;
    const int np = n0 + tx;
    int col = np;
    if (mode == 1) {
      const int r = np & 255;
      col = win_src_col((np & ~255) + ((r >> 5) & 3) * 64 + (r >> 7) * 32 + (r & 31));
    } else if (np >= N) col = -1;
#pragma unroll
    for (int i = 0; i < 8; ++i) {
      const int k = ty + 8 * i;
      float x = (col >= 0) ? src[(size_t)(k0 + k) * N + col] : 0.f;
      if (kscale) x *= kscale[k0 + k];
      v[i] = x;
    }
  };
  int tile = blockIdx.x;
  if (tile < ntile) load_tile(tile);
  for (; tile < ntile; tile += gridDim.x) {
    const int k0 = (tile % ntk) * 64, n0 = (tile / ntk) * 64;
#pragma unroll
    for (int i = 0; i < 8; ++i) tl[(ty + 8 * i) * 65 + tx] = v[i];
    __syncthreads();
    if (tile + (int)gridDim.x < ntile) load_tile(tile + gridDim.x);
#pragma unroll
    for (int i = 0; i < 8; ++i) {
      const int n = ty + 8 * i;
      dst[(size_t)(n0 + n) * K + k0 + tx] = f2bf(tl[tx * 65 + n]);
    }
    __syncthreads();
  }
}

DI void rmsnorm_rows(const float* src, const float* __restrict__ w, bfu* __restrict__ dst) {
  const int tidr = get_tid();
  const int lane = tidr & 63, wid = tidr >> 6;
  float4 ww[4];
#pragma unroll
  for (int i = 0; i < 4; ++i) ww[i] = *reinterpret_cast<const float4*>(w + i * 256 + lane * 4);
  for (int row0 = (blockIdx.x * 8 + wid) * 4; row0 < TT; row0 += gridDim.x * 8 * 4) {
    float4 v[4][4];
#pragma unroll
    for (int r = 0; r < 4; ++r)
#pragma unroll
      for (int i = 0; i < 4; ++i) v[r][i] = *reinterpret_cast<const float4*>(src + (size_t)(row0 + r) * 1024 + i * 256 + lane * 4);
#pragma unroll
    for (int r = 0; r < 4; ++r) {
      float ss = 0.f;
#pragma unroll
      for (int i = 0; i < 4; ++i) ss += v[r][i].x * v[r][i].x + v[r][i].y * v[r][i].y + v[r][i].z * v[r][i].z + v[r][i].w * v[r][i].w;
      ss = wave_sum(ss);
      const float sc = rsqrtf(ss * (1.f / 1024.f) + EPSF);
#pragma unroll
      for (int i = 0; i < 4; ++i)
        store4bf(dst + (size_t)(row0 + r) * 1024 + i * 256 + lane * 4, v[r][i].x * sc * ww[i].x, v[r][i].y * sc * ww[i].y, v[r][i].z * sc * ww[i].z, v[r][i].w * sc * ww[i].w);
    }
  }
}

constexpr float LOG2E = 1.4426950408889634f;
constexpr int KV_TILE = 64 * LSTR;
constexpr int NSA_OTOT_OFF = 8 * KV_TILE * 2;

DI void kv_gload(uint4& r0, uint4& r2, const bfu* K, const bfu* VT, int vstride) {
  const int id0 = get_tid();
  r0 = *reinterpret_cast<const uint4*>(K + (id0 >> 3) * 64 + (id0 & 7) * 8);
  r2 = *reinterpret_cast<const uint4*>(VT + (size_t)(id0 >> 3) * vstride + (id0 & 7) * 8);
}
DI void kv_sstore(const uint4& r0, const uint4& r2, bfu* buf) {
  const int id0 = get_tid();
  const int o = swz(id0 >> 3, id0 & 7);
  *reinterpret_cast<uint4*>(buf + o) = r0;
  *reinterpret_cast<uint4*>(buf + KV_TILE + o) = r2;
}
DI void st_compute(f32x4 (&sacc)[4][2], const bf16x8 (&qf)[2][2], const bfu* Kt, int c, int g, float cinit0, float cinit1) {
  const f32x4 ci[2] = {f32x4{cinit0, cinit0, cinit0, cinit0}, f32x4{cinit1, cinit1, cinit1, cinit1}};
#pragma unroll
  for (int mk = 0; mk < 4; ++mk) {
    const bf16x8 kf0 = *reinterpret_cast<const bf16x8*>(Kt + (16 * mk + c) * LSTR + (((0 + g) ^ (c >> 1)) << 3));
    const bf16x8 kf1 = *reinterpret_cast<const bf16x8*>(Kt + (16 * mk + c) * LSTR + (((4 + g) ^ (c >> 1)) << 3));
#pragma unroll
    for (int n = 0; n < 2; ++n) {
      sacc[mk][n] = __builtin_amdgcn_mfma_f32_16x16x32_bf16(kf0, qf[n][0], ci[n], 0, 0, 0);
      sacc[mk][n] = __builtin_amdgcn_mfma_f32_16x16x32_bf16(kf1, qf[n][1], sacc[mk][n], 0, 0, 0);
    }
  }
}
DI void pv_compute(f32x4 (&oacc)[4][2], const f32x4 (&p)[4][2], const bfu* VTt, int c, int g) {
#pragma unroll
  for (int kp = 0; kp < 2; ++kp) {
    bf16x8 pf[2];
#pragma unroll
    for (int n = 0; n < 2; ++n) {
      uint4 u;
      u.x = pack2(p[2 * kp][n][0], p[2 * kp][n][1]); u.y = pack2(p[2 * kp][n][2], p[2 * kp][n][3]);
      u.z = pack2(p[2 * kp + 1][n][0], p[2 * kp + 1][n][1]); u.w = pack2(p[2 * kp + 1][n][2], p[2 * kp + 1][n][3]);
      pf[n] = __builtin_bit_cast(bf16x8, u);
    }
#pragma unroll
    for (int md = 0; md < 4; ++md) {
      const bfu* vrow = VTt + (16 * md + c) * LSTR + (g & 1) * 4;
      const int ch0 = 4 * kp + (g >> 1);
      const uint2 lo = *reinterpret_cast<const uint2*>(vrow + ((ch0 ^ (c >> 1)) << 3));
      const uint2 hi = *reinterpret_cast<const uint2*>(vrow + (((ch0 + 2) ^ (c >> 1)) << 3));
      uint4 u; u.x = lo.x; u.y = lo.y; u.z = hi.x; u.w = hi.y;
      const bf16x8 vf = __builtin_bit_cast(bf16x8, u);
#pragma unroll
      for (int n = 0; n < 2; ++n) oacc[md][n] = __builtin_amdgcn_mfma_f32_16x16x32_bf16(vf, pf[n], oacc[md][n], 0, 0, 0);
    }
  }
}
DI void pv_compute_l(f32x4 (&oacc)[4][2], f32x4 (&lacc)[2], const f32x4 (&p)[4][2], const bfu* VTt, int c, int g, const bf16x8& onesf) {
#pragma unroll
  for (int kp = 0; kp < 2; ++kp) {
    bf16x8 pf[2];
#pragma unroll
    for (int n = 0; n < 2; ++n) {
      uint4 u;
      u.x = pack2(p[2 * kp][n][0], p[2 * kp][n][1]); u.y = pack2(p[2 * kp][n][2], p[2 * kp][n][3]);
      u.z = pack2(p[2 * kp + 1][n][0], p[2 * kp + 1][n][1]); u.w = pack2(p[2 * kp + 1][n][2], p[2 * kp + 1][n][3]);
      pf[n] = __builtin_bit_cast(bf16x8, u);
    }
#pragma unroll
    for (int n = 0; n < 2; ++n) lacc[n] = __builtin_amdgcn_mfma_f32_16x16x32_bf16(onesf, pf[n], lacc[n], 0, 0, 0);
#pragma unroll
    for (int md = 0; md < 4; ++md) {
      const bfu* vrow = VTt + (16 * md + c) * LSTR + (g & 1) * 4;
      const int ch0 = 4 * kp + (g >> 1);
      const uint2 lo = *reinterpret_cast<const uint2*>(vrow + ((ch0 ^ (c >> 1)) << 3));
      const uint2 hi = *reinterpret_cast<const uint2*>(vrow + (((ch0 + 2) ^ (c >> 1)) << 3));
      uint4 u; u.x = lo.x; u.y = lo.y; u.z = hi.x; u.w = hi.y;
      const bf16x8 vf = __builtin_bit_cast(bf16x8, u);
#pragma unroll
      for (int n = 0; n < 2; ++n) oacc[md][n] = __builtin_amdgcn_mfma_f32_16x16x32_bf16(vf, pf[n], oacc[md][n], 0, 0, 0);
    }
  }
}

template <int MODE>
DI void nsa_mask_edge(f32x4 (&sacc)[4][2], int jt, int qt, int ql0, int c, int g) {
  const bool diag = (jt == qt);
  const bool lowedge = (MODE == 1) && (jt == qt - 4);
  if (diag || lowedge) {
    int qlv = ql0 + c, klv = 4 * g;
    asm volatile("" : "+v"(qlv), "+v"(klv));
    const int dlt = qlv - klv;
#pragma unroll
    for (int mk = 0; mk < 4; ++mk)
#pragma unroll
      for (int n = 0; n < 2; ++n)
#pragma unroll
        for (int j = 0; j < 4; ++j) {
          const int off = 16 * mk + j - 16 * n;
          const bool v = diag ? (off <= dlt) : (off > dlt);
          sacc[mk][n][j] = v ? sacc[mk][n][j] : -1e30f;
        }
  }
}

template <int MODE, int PRE = 0>
DI void nsa_branch(f32x4 (&oacc)[4][2], float (&lrun)[2], const bf16x8 (&qf)[2][2], const bfu* Kb, const bfu* VTb,
                   unsigned tilemask, int qt, int ql0, const unsigned (&selb)[2], bfu* smem, int c, int g, float cshift,
                   uint4 p0 = uint4{0, 0, 0, 0}, uint4 p1 = uint4{0, 0, 0, 0}, uint4 p2 = uint4{0, 0, 0, 0}, uint4 p3 = uint4{0, 0, 0, 0}) {
  float mrun[2];
#pragma unroll
  for (int n = 0; n < 2; ++n) { mrun[n] = -1e30f; lrun[n] = 0.f; }
#pragma unroll
  for (int md = 0; md < 4; ++md)
#pragma unroll
    for (int n = 0; n < 2; ++n) oacc[md][n] = f32x4{0.f, 0.f, 0.f, 0.f};
  f32x4 lacc[2] = {f32x4{0.f, 0.f, 0.f, 0.f}, f32x4{0.f, 0.f, 0.f, 0.f}};
  bf16x8 onesf;
  { const short o_ = (c == 0) ? (short)0x3F80 : (short)0; onesf = bf16x8{o_, o_, o_, o_, o_, o_, o_, o_}; }
  uint4 r0, r1, r2, r3;
  unsigned tm = __builtin_amdgcn_readfirstlane(tilemask);
  int ja = __ffs(tm) - 1; tm &= tm - 1;
  int jb = -1;
  if (tm) { jb = __ffs(tm) - 1; tm &= tm - 1; }
  if (PRE) { r0 = p0; r1 = p1; r2 = p2; r3 = p3; }
  else {
    kv_gload(r0, r1, Kb + (size_t)ja * 64 * 64, VTb + ja * 64, 2048);
    if (jb >= 0) kv_gload(r2, r3, Kb + (size_t)jb * 64 * 64, VTb + jb * 64, 2048);
  }
  kv_sstore(r0, r1, smem);
  if (jb >= 0) kv_sstore(r2, r3, smem + 2 * KV_TILE);
  __syncthreads();
  int cur = 0;
  while (true) {
    int na = -1, nb = -1;
    if (tm) { na = __ffs(tm) - 1; tm &= tm - 1; }
    if (tm) { nb = __ffs(tm) - 1; tm &= tm - 1; }
    if (na >= 0) kv_gload(r0, r1, Kb + (size_t)na * 64 * 64, VTb + na * 64, 2048);
    if (nb >= 0) kv_gload(r2, r3, Kb + (size_t)nb * 64 * 64, VTb + nb * 64, 2048);
    __builtin_amdgcn_sched_barrier(0);
    const bfu* St = smem + cur * 4 * KV_TILE;
    f32x4 sA[4][2], sB[4][2];
    float tmax[2];
#pragma unroll
    for (int n = 0; n < 2; ++n) tmax[n] = -1e30f;
    {
      const float i0 = (MODE == 0 && !((selb[0] >> ja) & 1u)) ? -1e30f : -cshift, i1 = (MODE == 0 && !((selb[1] >> ja) & 1u)) ? -1e30f : -cshift;
      st_compute(sA, qf, St, c, g, i0, i1);
      nsa_mask_edge<MODE>(sA, ja, qt, ql0, c, g);
    }
    if (jb >= 0) {
      const float i0 = (MODE == 0 && !((selb[0] >> jb) & 1u)) ? -1e30f : -cshift, i1 = (MODE == 0 && !((selb[1] >> jb) & 1u)) ? -1e30f : -cshift;
      st_compute(sB, qf, St + 2 * KV_TILE, c, g, i0, i1);
      nsa_mask_edge<MODE>(sB, jb, qt, ql0, c, g);
    }
#pragma unroll
    for (int mk = 0; mk < 4; ++mk)
#pragma unroll
      for (int n = 0; n < 2; ++n)
#pragma unroll
        for (int j = 0; j < 4; ++j) sA[mk][n][j] = __builtin_amdgcn_exp2f(sA[mk][n][j]);
    __builtin_amdgcn_sched_barrier(0);
    if (na >= 0) kv_sstore(r0, r1, smem + (cur ^ 1) * 4 * KV_TILE);
    if (nb >= 0) kv_sstore(r2, r3, smem + (cur ^ 1) * 4 * KV_TILE + 2 * KV_TILE);
    __builtin_amdgcn_sched_barrier(0);
    pv_compute_l(oacc, lacc, sA, St + KV_TILE, c, g, onesf);
    if (jb >= 0) {
#pragma unroll
      for (int mk = 0; mk < 4; ++mk)
#pragma unroll
        for (int n = 0; n < 2; ++n)
#pragma unroll
          for (int j = 0; j < 4; ++j) sB[mk][n][j] = __builtin_amdgcn_exp2f(sB[mk][n][j]);
      pv_compute_l(oacc, lacc, sB, St + 3 * KV_TILE, c, g, onesf);
    }
    __syncthreads();
    if (na < 0) break;
    ja = na; jb = nb; cur ^= 1;
  }
#pragma unroll
  for (int n = 0; n < 2; ++n) lrun[n] = __shfl(lacc[n][0], c);
}

DI void nsa_item(unsigned char* ws, int item, unsigned char* smem_raw, bool load_cmp) {
  const int tid = get_tid(), lane = tid & 63, w = __builtin_amdgcn_readfirstlane(tid >> 6), c = lane & 15, g = lane >> 4;
  const int hw = w & 3, hq = w >> 2, ql0 = 32 * hq;
  int qt;
  { const int k = item >> 5; qt = (k < 16) ? (31 - k) : (k - 16); }
  const int bg = item & 31;
  const int b = bg >> 1, gk = bg & 1, h = gk * 4 + hw;
  bfu* smem = reinterpret_cast<bfu*>(smem_raw);
  uint2* otot = reinterpret_cast<uint2*>(smem_raw + NSA_OTOT_OFF) + (size_t)(w * 8) * 64 + lane;
  float* part = reinterpret_cast<float*>(smem_raw + NSA_OTOT_OFF);
  float* score = reinterpret_cast<float*>(smem_raw);
  unsigned* selm = reinterpret_cast<unsigned*>(smem_raw + 64 * 33 * 4);
  const int sq0 = 64 * qt + ql0;
  const bfu* Qb = reinterpret_cast<const bfu*>(ws + O_QN) + ((size_t)(b * 8 + h) * 2048 + sq0) * 64;
  const bfu* Kcmp = reinterpret_cast<const bfu*>(ws + O_KCMP) + (size_t)bg * 128 * 64;
  const bfu* VcmpT = reinterpret_cast<const bfu*>(ws + O_VCMPT) + (size_t)bg * 64 * 128;
  const float* Gt = reinterpret_cast<const float*>(ws + O_GT);
  const size_t t0 = (size_t)b * 2048 + sq0;

  bf16x8 qf[2][2];
#pragma unroll
  for (int n = 0; n < 2; ++n)
#pragma unroll
    for (int ks = 0; ks < 2; ++ks) qf[n][ks] = *reinterpret_cast<const bf16x8*>(Qb + (16 * n + c) * 64 + 32 * ks + 8 * g);

  const bfu* Kw = reinterpret_cast<const bfu*>(ws + O_KW) + (size_t)bg * 2048 * 64;
  const bfu* VwT = reinterpret_cast<const bfu*>(ws + O_VWT) + (size_t)bg * 64 * 2048;
  unsigned wm = 0u;
  for (int j = (qt >= 4 ? qt - 4 : 0); j <= qt; ++j) wm |= 1u << j;
  f32x4 oacc[4][2];
  bfu* cmpb = reinterpret_cast<bfu*>(smem_raw + 100352);
  {
    if (load_cmp) {
      uint4 r0, r2;
      kv_gload(r0, r2, Kcmp, VcmpT, 128); kv_sstore(r0, r2, cmpb);
      kv_gload(r0, r2, Kcmp + 64 * 64, VcmpT + 64, 128); kv_sstore(r0, r2, cmpb + 2 * KV_TILE);
    }
    const bool t1 = (qt >= 16);
    __syncthreads();
    f32x4 s0[4][2], s1[4][2];
    st_compute(s0, qf, cmpb, c, g, 0.f, 0.f);
    if (t1) st_compute(s1, qf, cmpb + 2 * KV_TILE, c, g, 0.f, 0.f);
    else {
#pragma unroll
      for (int mk = 0; mk < 4; ++mk)
#pragma unroll
        for (int n = 0; n < 2; ++n) s1[mk][n] = f32x4{0.f, 0.f, 0.f, 0.f};
    }
    int ncv[2]; float mx[2], ls[2];
#pragma unroll
    for (int n = 0; n < 2; ++n) { const int qp = sq0 + 16 * n + c; ncv[n] = (qp >= 31) ? ((qp - 31) / 16 + 1) : 0; mx[n] = -1e30f; ls[n] = 0.f; }
#pragma unroll
    for (int mk = 0; mk < 4; ++mk)
#pragma unroll
      for (int n = 0; n < 2; ++n)
#pragma unroll
        for (int j = 0; j < 4; ++j) {
          const int ci = 16 * mk + 4 * g + j;
          const float v0 = (ci < ncv[n]) ? s0[mk][n][j] : -1e30f;
          const float v1 = (ci + 64 < ncv[n]) ? s1[mk][n][j] : -1e30f;
          s0[mk][n][j] = v0; s1[mk][n][j] = v1;
          mx[n] = fmax_fast(mx[n], fmax_fast(v0, v1));
        }
#pragma unroll
    for (int n = 0; n < 2; ++n) { float t = mx[n]; t = fmax_fast(t, __shfl_xor(t, 16)); t = fmax_fast(t, __shfl_xor(t, 32)); mx[n] = t; }
#pragma unroll
    for (int mk = 0; mk < 4; ++mk)
#pragma unroll
      for (int n = 0; n < 2; ++n)
#pragma unroll
        for (int j = 0; j < 4; ++j) {
          const float mxb = fmax_fast(mx[n], -1e20f);
          const float p0 = __builtin_amdgcn_exp2f(s0[mk][n][j] - mxb);
          const float p1 = __builtin_amdgcn_exp2f(s1[mk][n][j] - mxb);
          s0[mk][n][j] = p0; s1[mk][n][j] = p1; ls[n] += p0 + p1;
        }
#pragma unroll
    for (int n = 0; n < 2; ++n) {
      float l = ls[n]; l += __shfl_xor(l, 16); l += __shfl_xor(l, 32);
      const float inv = (l > 0.f) ? 1.f / l : 0.f;
#pragma unroll
      for (int mk = 0; mk < 4; ++mk)
#pragma unroll
        for (int j = 0; j < 4; ++j) { s0[mk][n][j] *= inv; s1[mk][n][j] *= inv; }
    }
#pragma unroll
    for (int n = 0; n < 2; ++n) {
      float prev3 = 0.f;
#pragma unroll
      for (int tt = 0; tt < 2; ++tt)
#pragma unroll
        for (int mk = 0; mk < 4; ++mk) {
          const f32x4 pv = tt ? s1[mk][n] : s0[mk][n];
          const float sum4 = pv[0] + pv[1] + pv[2] + pv[3];
          const float send = (g == 3) ? prev3 : pv[3];
          const float recv = __shfl(send, (lane + 48) & 63);
          part[(hw * 64 + ql0 + 16 * n + c) * 33 + 16 * tt + 4 * mk + g] = sum4 + recv;
          prev3 = pv[3];
        }
    }
#pragma unroll
    for (int md = 0; md < 4; ++md)
#pragma unroll
      for (int n = 0; n < 2; ++n) oacc[md][n] = f32x4{0.f, 0.f, 0.f, 0.f};
    pv_compute(oacc, s0, cmpb + KV_TILE, c, g);
    if (t1) pv_compute(oacc, s1, cmpb + 3 * KV_TILE, c, g);
#pragma unroll
    for (int n = 0; n < 2; ++n) {
      const float g0 = Gt[(t0 + 16 * n + c) * 24 + h];
#pragma unroll
      for (int md = 0; md < 4; ++md) { oacc[md][n][0] *= g0; oacc[md][n][1] *= g0; oacc[md][n][2] *= g0; oacc[md][n][3] *= g0; }
    }
  }
  __syncthreads();
  {
    const int q = tid >> 3, p8 = tid & 7;
    if (tid == 0) selm[64] = 0u;
#pragma unroll
    for (int jj = 0; jj < 4; ++jj) {
      const int j = p8 * 4 + jj;
      const float v = part[(0 * 64 + q) * 33 + j] + part[(1 * 64 + q) * 33 + j] + part[(2 * 64 + q) * 33 + j] + part[(3 * 64 + q) * 33 + j];
      const bool forced = (j == 0) || (j == qt) || (j == qt - 1);
      score[q * 33 + j] = forced ? 1.0e4f : ((j <= qt) ? v : -1.f);
    }
    __syncthreads();
    float mine[4]; int rank[4];
#pragma unroll
    for (int jj = 0; jj < 4; ++jj) { mine[jj] = score[q * 33 + p8 * 4 + jj]; rank[jj] = 0; }
#pragma unroll 8
    for (int j2 = 0; j2 < 32; ++j2) {
      const float o = score[q * 33 + j2];
      const int d2 = j2 - p8 * 4;
#pragma unroll
      for (int jj = 0; jj < 4; ++jj) rank[jj] += (int)(o > mine[jj]) + (int)((o == mine[jj]) & (d2 < jj));
    }
    unsigned bits = 0u;
#pragma unroll
    for (int jj = 0; jj < 4; ++jj) if (rank[jj] < 8) bits |= 1u << (p8 * 4 + jj);
    bits |= __shfl_xor(bits, 1); bits |= __shfl_xor(bits, 2); bits |= __shfl_xor(bits, 4);
    if (p8 == 0) { selm[q] = bits; atomicOr(&selm[64], bits); }
    __syncthreads();
  }
  unsigned selb[2];
#pragma unroll
  for (int n = 0; n < 2; ++n) selb[n] = selm[ql0 + 16 * n + c];
  const unsigned umask = selm[64] & ((qt == 31) ? 0xffffffffu : ((2u << qt) - 1u));
#pragma unroll
  for (int md = 0; md < 4; ++md)
#pragma unroll
    for (int n = 0; n < 2; ++n) {
      uint2 v; v.x = pack2(oacc[md][n][0], oacc[md][n][1]); v.y = pack2(oacc[md][n][2], oacc[md][n][3]);
      otot[(md * 2 + n) * 64] = v;
    }
  __syncthreads();
  float lrun[2];
  {
    const bfu* Ks = reinterpret_cast<const bfu*>(ws + O_KS) + (size_t)bg * 2048 * 64;
    const bfu* VsT = reinterpret_cast<const bfu*>(ws + O_VST) + (size_t)bg * 64 * 2048;
    nsa_branch<0>(oacc, lrun, qf, Ks, VsT, umask, qt, ql0, selb, smem, c, g, reinterpret_cast<const float*>(ws + O_CSH)[0]);
#pragma unroll
    for (int n = 0; n < 2; ++n) {
      const float g1 = Gt[(t0 + 16 * n + c) * 24 + 8 + h] / lrun[n];
#pragma unroll
      for (int md = 0; md < 4; ++md) {
        const uint2 v = otot[(md * 2 + n) * 64];
        const float o0 = __uint_as_float(v.x << 16) + g1 * oacc[md][n][0];
        const float o1 = __uint_as_float(v.x & 0xffff0000u) + g1 * oacc[md][n][1];
        const float o2 = __uint_as_float(v.y << 16) + g1 * oacc[md][n][2];
        const float o3 = __uint_as_float(v.y & 0xffff0000u) + g1 * oacc[md][n][3];
        uint2 u; u.x = pack2(o0, o1); u.y = pack2(o2, o3);
        otot[(md * 2 + n) * 64] = u;
      }
    }
  }
  {
    nsa_branch<1>(oacc, lrun, qf, Kw, VwT, wm, qt, ql0, selb, smem, c, g, reinterpret_cast<const float*>(ws + O_CSH)[1]);
    bfu* mix = reinterpret_cast<bfu*>(ws + O_MIX);
#pragma unroll
    for (int n = 0; n < 2; ++n) {
      const float g2 = Gt[(t0 + 16 * n + c) * 24 + 16 + h] / lrun[n];
      bfu* md_ = mix + (t0 + 16 * n + c) * 1024 + h * 64 + 4 * g;
#pragma unroll
      for (int md = 0; md < 4; ++md) {
        const uint2 v = otot[(md * 2 + n) * 64];
        const float o0 = __uint_as_float(v.x << 16) + g2 * oacc[md][n][0];
        const float o1 = __uint_as_float(v.x & 0xffff0000u) + g2 * oacc[md][n][1];
        const float o2 = __uint_as_float(v.y << 16) + g2 * oacc[md][n][2];
        const float o3 = __uint_as_float(v.y & 0xffff0000u) + g2 * oacc[md][n][3];
        store4bf(md_ + 16 * md, o0, o1, o2, o3);
      }
    }
  }
}

struct EpiKV {
  float* dst;
  DI void operator()(int row0, int col0, f32x4 (&acc)[4][4]) const {
    if (col0 != 0 || row0 >= 128) return;
    const int lane = get_tid() & 63, c = lane & 15, g = lane >> 4;
#pragma unroll
    for (int m = 0; m < 4; ++m)
#pragma unroll
      for (int n = 0; n < 4; ++n) {
        float4 v; v.x = acc[m][n][0]; v.y = acc[m][n][1]; v.z = acc[m][n][2]; v.w = acc[m][n][3];
        *reinterpret_cast<float4*>(dst + (size_t)(row0 + 16 * m + c) * 64 + 16 * n + 4 * g) = v;
      }
  }
};

constexpr int RSTR_V = 136;
DI void ret_item(const float* ret_norm_w, unsigned char* ws, int item, unsigned char* smem_raw) {
  const int tid = get_tid(), lane = tid & 63, w = __builtin_amdgcn_readfirstlane(tid >> 6), c = lane & 15, g = lane >> 4;
  const int bh = item >> 4, ch = item & 15, b = bh >> 2, h = bh & 3;
  bfu* Kt = reinterpret_cast<bfu*>(smem_raw);
  bfu* St = Kt + 128 * RSTR_K;
  bfu* VTt = St + 128 * RSTR_K;
  const float l2g = ret_log2gamma(h);
  {
    const bfu* Rk = reinterpret_cast<const bfu*>(ws + O_RK) + ((size_t)bh * 2048 + ch * 128) * 64;
#pragma unroll
    for (int i = 0; i < 2; ++i) {
      const int id = tid + 512 * i, row = id >> 3, cc = id & 7;
      *reinterpret_cast<uint4*>(Kt + row * RSTR_K + cc * 8) = *reinterpret_cast<const uint4*>(Rk + row * 64 + cc * 8);
    }
    const bfu* RvT = reinterpret_cast<const bfu*>(ws + O_RVT) + ((size_t)bh * 128) * 2048 + ch * 128;
#pragma unroll
    for (int i = 0; i < 4; ++i) {
      const int id = tid + 512 * i, row = id >> 4, cc = id & 15;
      *reinterpret_cast<uint4*>(VTt + row * RSTR_V + cc * 8) = *reinterpret_cast<const uint4*>(RvT + (size_t)row * 2048 + cc * 8);
    }
    const bfu* Sg = reinterpret_cast<const bfu*>(ws + O_STATE) + (size_t)item * 8192;
#pragma unroll
    for (int i = 0; i < 2; ++i) {
      const int id = tid + 512 * i, row = id >> 3, cc = id & 7;
      *reinterpret_cast<uint4*>(St + row * RSTR_K + cc * 8) = *reinterpret_cast<const uint4*>(Sg + row * 64 + cc * 8);
    }
  }
  __syncthreads();
  bf16x8 qf[2], qxf[2];
  {
    const bfu* Rq = reinterpret_cast<const bfu*>(ws + O_RQ) + ((size_t)bh * 2048 + ch * 128 + 16 * w) * 64;
    const bfu* Rqx = reinterpret_cast<const bfu*>(ws + O_RQX) + ((size_t)bh * 2048 + ch * 128 + 16 * w) * 64;
#pragma unroll
    for (int ks = 0; ks < 2; ++ks) {
      qf[ks] = *reinterpret_cast<const bf16x8*>(Rq + c * 64 + 32 * ks + 8 * g);
      qxf[ks] = *reinterpret_cast<const bf16x8*>(Rqx + c * 64 + 32 * ks + 8 * g);
    }
  }
  f32x4 sacc[8];
#pragma unroll
  for (int mk = 0; mk < 8; ++mk) {
    sacc[mk] = f32x4{0.f, 0.f, 0.f, 0.f};
    if (mk <= w) {
#pragma unroll
      for (int ks = 0; ks < 2; ++ks) {
        const bf16x8 kf = *reinterpret_cast<const bf16x8*>(Kt + (16 * mk + c) * RSTR_K + 32 * ks + 8 * g);
        sacc[mk] = __builtin_amdgcn_mfma_f32_16x16x32_bf16(kf, qf[ks], sacc[mk], 0, 0, 0);
      }
#pragma unroll
      for (int j = 0; j < 4; ++j) {
        const int d = (16 * w + c) - (16 * mk + 4 * g + j);
        sacc[mk][j] = (d >= 0) ? sacc[mk][j] * exp2f(l2g * (float)d) : 0.f;
      }
    }
  }
  f32x4 oacc[8];
#pragma unroll
  for (int md = 0; md < 8; ++md) oacc[md] = f32x4{0.f, 0.f, 0.f, 0.f};
#pragma unroll
  for (int kp = 0; kp < 4; ++kp) {
    if (2 * kp <= w) {
      uint4 u;
      u.x = pack2(sacc[2 * kp][0], sacc[2 * kp][1]); u.y = pack2(sacc[2 * kp][2], sacc[2 * kp][3]);
      u.z = pack2(sacc[2 * kp + 1][0], sacc[2 * kp + 1][1]); u.w = pack2(sacc[2 * kp + 1][2], sacc[2 * kp + 1][3]);
      const bf16x8 pf = __builtin_bit_cast(bf16x8, u);
#pragma unroll
      for (int md = 0; md < 8; ++md) {
        const bfu* vp = VTt + (16 * md + c) * RSTR_V + 32 * kp + 4 * g;
        const uint2 lo = *reinterpret_cast<const uint2*>(vp);
        const uint2 hi = *reinterpret_cast<const uint2*>(vp + 16);
        uint4 uu; uu.x = lo.x; uu.y = lo.y; uu.z = hi.x; uu.w = hi.y;
        const bf16x8 vf = __builtin_bit_cast(bf16x8, uu);
        oacc[md] = __builtin_amdgcn_mfma_f32_16x16x32_bf16(vf, pf, oacc[md], 0, 0, 0);
      }
    }
  }
#pragma unroll
  for (int ks = 0; ks < 2; ++ks)
#pragma unroll
    for (int md = 0; md < 8; ++md) {
      const bf16x8 sf = *reinterpret_cast<const bf16x8*>(St + (16 * md + c) * RSTR_K + 32 * ks + 8 * g);
      oacc[md] = __builtin_amdgcn_mfma_f32_16x16x32_bf16(sf, qxf[ks], oacc[md], 0, 0, 0);
    }
  const float* rnw = ret_norm_w + h * 128;
  const bfu* Rg = reinterpret_cast<const bfu*>(ws + O_RG);
  bfu* mix = reinterpret_cast<bfu*>(ws + O_MIX);
  {
    float sm = 0.f;
#pragma unroll
    for (int md = 0; md < 8; ++md) sm += oacc[md][0] + oacc[md][1] + oacc[md][2] + oacc[md][3];
    sm += __shfl_xor(sm, 16); sm += __shfl_xor(sm, 32);
    const float mu = sm * (1.f / 128.f);
    float vs = 0.f;
#pragma unroll
    for (int md = 0; md < 8; ++md)
#pragma unroll
      for (int j = 0; j < 4; ++j) { const float d = oacc[md][j] - mu; oacc[md][j] = d; vs += d * d; }
    vs += __shfl_xor(vs, 16); vs += __shfl_xor(vs, 32);
    const float rs = rsqrtf(vs * (1.f / 128.f) + EPSF);
    const size_t t = (size_t)b * 2048 + ch * 128 + 16 * w + c;
#pragma unroll
    for (int md = 0; md < 8; ++md) {
      const int dv = 16 * md + 4 * g;
      const float4 wv = *reinterpret_cast<const float4*>(rnw + dv);
      const uint2 gg = *reinterpret_cast<const uint2*>(Rg + t * 512 + h * 128 + dv);
      const float o0 = oacc[md][0] * rs * wv.x * __uint_as_float(gg.x << 16);
      const float o1 = oacc[md][1] * rs * wv.y * __uint_as_float(gg.x & 0xffff0000u);
      const float o2 = oacc[md][2] * rs * wv.z * __uint_as_float(gg.y << 16);
      const float o3 = oacc[md][3] * rs * wv.w * __uint_as_float(gg.y & 0xffff0000u);
      store4bf(mix + t * 1024 + 512 + h * 128 + dv, o0, o1, o2, o3);
    }
  }
  __syncthreads();
}

constexpr int NPHASE = 9;
#ifndef ONLY_PH
#define ONLY_PH -1
#endif
#define PH_ON(k) (ONLY_PH < 0 || ONLY_PH == (k))
#ifndef REP_PH
#define REP_PH -1
#endif
#define PHASE_ARGS const Args& a = a0; unsigned char* ws = a0.ws;
DI void phase1(unsigned char* ws, const float* pa, const float* pb, float* out) {
  extern __shared__ __attribute__((aligned(16))) unsigned char smem_raw[];
  bfu* smem = reinterpret_cast<bfu*>(smem_raw);
      EpiProj epi{ws, pa, pb};
      const bfu* Am = reinterpret_cast<const bfu*>(ws + O_XN);
      const bfu* Bt = reinterpret_cast<const bfu*>(ws + O_WINT);
      for (int it = 0;; ++it) {
        int mt, nt; if (!tile_map(it, 128, 12, mt, nt)) break;
        gemm8p_tile<1>(Am, Bt, 1024, mt * 256, nt * 256, epi);
      }
}
DI void phase2(unsigned char* ws, const float* pa, const float* pb, float* out) {
  extern __shared__ __attribute__((aligned(16))) unsigned char smem_raw[];
  bfu* smem = reinterpret_cast<bfu*>(smem_raw);
      if (blockIdx.x == gridDim.x - 1) {
        const int t_ = get_tid();
        const float* bp_ = reinterpret_cast<const float*>(ws + O_B1P);
        const int kv = t_ >> 8, n = t_ & 255;
        float acc_ = 0.f;
#pragma unroll
        for (int kq = 0; kq < 16; ++kq) acc_ += bp_[(kv * 16 + kq) * 256 + n];
        reinterpret_cast<float*>(ws + (kv ? O_B1V : O_B1K))[n] = acc_;
      }
      for (int item = blockIdx.x; item < 256 + 1024; item += gridDim.x) {
        if (item < 256) {
          const int ks = item & 3, nt = (item >> 2) & 1, mt = (item >> 3) & 15, kv = item >> 7;
          EpiCmp1 epi{reinterpret_cast<float*>(ws + O_HACC) + (size_t)(ks * 2 + kv) * 4096 * 256};
          ARowCmp ar{reinterpret_cast<const bfu*>(ws + (kv ? O_VC : O_KC)) + ks * 512};
          gemm_tile<4>(ar, ARowPlain{reinterpret_cast<const bfu*>(ws + (kv ? O_WV1T : O_WK1T)) + ks * 512, 2048}, 512, mt * 256, nt * 128, epi, smem);
        } else {
          const int it = item - 256, bh = it >> 4, ch = it & 15;
          EpiKV epi{reinterpret_cast<float*>(ws + O_KVT) + (size_t)it * 8192};
          ARowClamp128 ar{reinterpret_cast<const bfu*>(ws + O_RVT) + (size_t)bh * 128 * 2048 + ch * 128, 2048};
          BRowClamp64 br{reinterpret_cast<const bfu*>(ws + O_RKTZ) + (size_t)bh * 64 * 2048 + ch * 128, 2048};
          gemm_tile<4>(ar, br, 128, 0, 0, epi, smem);
        }
      }
}
DI void phase3(unsigned char* ws, const float* pa, const float* pb, float* out) {
  extern __shared__ __attribute__((aligned(16))) unsigned char smem_raw[];
  bfu* smem = reinterpret_cast<bfu*>(smem_raw);
      for (int item = (int)gridDim.x - 1 - (int)blockIdx.x; item < 256; item += gridDim.x) {
        const int bh = item >> 2, q = item & 3, h = bh & 3;
        const int e = q * 2048 + get_tid() * 4;
        const float gC = exp2f(ret_log2gamma(h) * 128.f);
        const float* KVt = reinterpret_cast<const float*>(ws + O_KVT) + (size_t)(bh * 16) * 8192 + e;
        bfu* Sg = reinterpret_cast<bfu*>(ws + O_STATE) + (size_t)(bh * 16) * 8192 + e;
        float4 kvv[15];
#pragma unroll
        for (int cc = 0; cc < 15; ++cc) kvv[cc] = *reinterpret_cast<const float4*>(KVt + (size_t)cc * 8192);
        float4 st = {0.f, 0.f, 0.f, 0.f};
        store4bf(Sg, 0.f, 0.f, 0.f, 0.f);
#pragma unroll
        for (int cc = 0; cc < 15; ++cc) {
          st.x = st.x * gC + kvv[cc].x; st.y = st.y * gC + kvv[cc].y; st.z = st.z * gC + kvv[cc].z; st.w = st.w * gC + kvv[cc].w;
          store4bf(Sg + (size_t)(cc + 1) * 8192, st.x, st.y, st.z, st.w);
        }
      }
      for (int item = blockIdx.x; item < 32; item += gridDim.x) {
        const int kv = item >> 4, mt = item & 15;
        EpiCmp2 epi{reinterpret_cast<bfu*>(ws + (kv ? O_VCMPT : O_KCMP)), kv};
        ARowPlain ar{reinterpret_cast<const bfu*>(ws + O_HACC + (size_t)kv * 4096 * 256 * 4), 512};
        gemm_tile<4, 1>(ar, ARowPlain{reinterpret_cast<const bfu*>(ws + (kv ? O_WV2T : O_WK2T)), 256}, 256, mt * 256, 0, epi, smem,
                        reinterpret_cast<const float*>(ws + (kv ? O_B1V : O_B1K)));
      }
    }
DI void phase4(unsigned char* ws, const float* pa, const float* pb, float* out) {
  extern __shared__ __attribute__((aligned(16))) unsigned char smem_raw[];
  bfu* smem = reinterpret_cast<bfu*>(smem_raw);
      {
        int prev_bg = -1;
        for (int item = blockIdx.x; item < 1024; item += gridDim.x) { const int bg_ = item & 31; nsa_item(ws, item, smem_raw, bg_ != prev_bg); prev_bg = bg_; }
      }
      for (int item = blockIdx.x; item < 1024; item += gridDim.x) ret_item(pa, ws, item, smem_raw);
      if (REP_PH == 42) { for (int item = blockIdx.x; item < 1024; item += gridDim.x) ret_item(pa, ws, item, smem_raw); }
      if (REP_PH == 42) { for (int item = blockIdx.x; item < 1024; item += gridDim.x) ret_item(pa, ws, item, smem_raw); }
    }
DI void phase5(unsigned char* ws, const float* pa, const float* pb, float* out) {
  extern __shared__ __attribute__((aligned(16))) unsigned char smem_raw[];
  bfu* smem = reinterpret_cast<bfu*>(smem_raw);
      EpiOut2 epi{pa, out, reinterpret_cast<bfu*>(ws + O_XN), reinterpret_cast<float*>(ws + O_SS2)};
      const bfu* Am = reinterpret_cast<const bfu*>(ws + O_MIX);
      const bfu* Bt = reinterpret_cast<const bfu*>(ws + O_WOUTT);
      for (int it = 0;; ++it) {
        int mt, nt; if (!tile_map(it, 128, 4, mt, nt)) break;
        gemm8p_tile(Am, Bt, 1024, mt * 256, nt * 256, epi);
      }
    }
DI void phase6(unsigned char* ws, const float* pa, const float* pb, float* out) {
  extern __shared__ __attribute__((aligned(16))) unsigned char smem_raw[];
  bfu* smem = reinterpret_cast<bfu*>(smem_raw);
      rmsnorm_rows(out, pa, reinterpret_cast<bfu*>(ws + O_XN));
    }
DI void phase7(unsigned char* ws, const float* pa, const float* pb, float* out) {
  extern __shared__ __attribute__((aligned(16))) unsigned char smem_raw[];
  bfu* smem = reinterpret_cast<bfu*>(smem_raw);
      EpiUp2 epi{reinterpret_cast<bfu*>(ws + O_ACT), reinterpret_cast<const float*>(ws + O_SS2)};
      const bfu* Am = reinterpret_cast<const bfu*>(ws + O_XN);
      const bfu* Bt = reinterpret_cast<const bfu*>(ws + O_WUPT);
      for (int it = 0;; ++it) {
        int mt, nt; if (!tile_map(it, 128, 16, mt, nt)) break;
        gemm8p_tile(Am, Bt, 1024, mt * 256, nt * 256, epi);
      }
    }
DI void phase8(unsigned char* ws, const float* pa, const float* pb, float* out) {
  extern __shared__ __attribute__((aligned(16))) unsigned char smem_raw[];
  bfu* smem = reinterpret_cast<bfu*>(smem_raw);
      EpiDown2 epi{out, reinterpret_cast<const bfu*>(ws + O_XN)};
      const bfu* Am = reinterpret_cast<const bfu*>(ws + O_ACT);
      const bfu* Bt = reinterpret_cast<const bfu*>(ws + O_WDOWNT);
      for (int it = 0;; ++it) {
        int mt, nt; if (!tile_map(it, 128, 4, mt, nt)) break;
        gemm8p_tile(Am, Bt, 4096, mt * 256, nt * 256, epi);
      }
    }

struct GBar { unsigned* w; unsigned x, nloc, nx; };
DI unsigned gb_xcc_id() { return (unsigned)__builtin_amdgcn_s_getreg((3 << 11) | 20) & 0xFu; }
DI void gbar(GBar& b, unsigned k) {
  asm volatile("s_waitcnt vmcnt(0)" ::: "memory");
  __syncthreads();
  if (threadIdx.x == 0) {
    asm volatile("s_waitcnt vmcnt(0) lgkmcnt(0)" ::: "memory");
    if (b.nloc == 0u) {
      for (;;) {
        unsigned sum = 0u, cnt = 0u, mine = 0u;
#pragma unroll
        for (unsigned j = 0; j < 16; ++j) { const unsigned cc = __hip_atomic_load(b.w + 256 + 64 * j, __ATOMIC_RELAXED, __HIP_MEMORY_SCOPE_AGENT); sum += cc; cnt += (cc > 0u) ? 1u : 0u; mine = (j == b.x) ? cc : mine; }
        if (sum == gridDim.x) { b.nloc = mine; b.nx = cnt; break; }
        __builtin_amdgcn_s_sleep(1);
      }
    }
    unsigned* xsub = b.w + 1280 + 64 * b.x; unsigned* xgen = b.w + 2304 + 64 * b.x; unsigned* top = b.w + 3328; unsigned* topgen = b.w + 3392;
    const unsigned old = __hip_atomic_fetch_add(xsub, 1u, __ATOMIC_RELAXED, __HIP_MEMORY_SCOPE_AGENT);
    if (old + 1u == k * b.nloc) {
      __builtin_amdgcn_fence(__ATOMIC_RELEASE, "agent");
      asm volatile("s_waitcnt vmcnt(0)" ::: "memory");
      const unsigned og = __hip_atomic_fetch_add(top, 1u, __ATOMIC_RELAXED, __HIP_MEMORY_SCOPE_AGENT);
      if (og + 1u == k * b.nx) __hip_atomic_fetch_add(topgen, 1u, __ATOMIC_RELAXED, __HIP_MEMORY_SCOPE_AGENT);
      else while (__hip_atomic_load(topgen, __ATOMIC_RELAXED, __HIP_MEMORY_SCOPE_AGENT) < k) __builtin_amdgcn_s_sleep(1);
      __builtin_amdgcn_fence(__ATOMIC_ACQUIRE, "agent");
      __hip_atomic_fetch_add(xgen, 1u, __ATOMIC_RELAXED, __HIP_MEMORY_SCOPE_AGENT);
      asm volatile("s_waitcnt vmcnt(0)" ::: "memory");
    } else {
      while (__hip_atomic_load(xgen, __ATOMIC_RELAXED, __HIP_MEMORY_SCOPE_AGENT) < k) __builtin_amdgcn_s_sleep(1);
      __builtin_amdgcn_fence(__ATOMIC_ACQUIRE, "agent");
      asm volatile("s_waitcnt vmcnt(0)" ::: "memory");
    }
  }
  __syncthreads();
}

__global__ void __launch_bounds__(512) mega(Args a0) {
  extern __shared__ __attribute__((aligned(16))) unsigned char smem_raw[];
  float* smf = reinterpret_cast<float*>(smem_raw);
  cg::grid_group grid = cg::this_grid();
  const int tid = threadIdx.x;
  GBar gb; gb.w = reinterpret_cast<unsigned*>(a0.ws + O_BAR); gb.x = gb_xcc_id(); gb.nloc = 0u; gb.nx = 0u;
  if (threadIdx.x == 0) __hip_atomic_fetch_add(gb.w + 256 + 64 * gb.x, 1u, __ATOMIC_RELAXED, __HIP_MEMORY_SCOPE_AGENT);
  {
    for (int rep0 = 0; rep0 < (REP_PH == 0 ? 2 : 1); ++rep0) {
      if (rep0) grid.sync();
      PHASE_ARGS
      tconv(a.in[2], 1024, NIN, reinterpret_cast<bfu*>(ws + O_WINT), NINP, 1, smf);
      tconv(a.in[12], 1024, 1024, reinterpret_cast<bfu*>(ws + O_WOUTT), 1024, 0, smf);
      tconv(a.in[14], 1024, 4096, reinterpret_cast<bfu*>(ws + O_WUPT), 4096, 0, smf, a.in[13]);
      tconv(a.in[15], 4096, 1024, reinterpret_cast<bfu*>(ws + O_WDOWNT), 1024, 0, smf);
      tconv(a.in[7], 2048, 256, reinterpret_cast<bfu*>(ws + O_WK1T), 256, 0, smf);
      tconv(a.in[9], 2048, 256, reinterpret_cast<bfu*>(ws + O_WV1T), 256, 0, smf);
      tconv(a.in[8], 256, 64, reinterpret_cast<bfu*>(ws + O_WK2T), 128, 0, smf);
      tconv(a.in[10], 256, 64, reinterpret_cast<bfu*>(ws + O_WV2T), 128, 0, smf);
      {
        float4* z1 = reinterpret_cast<float4*>(ws + O_SS2);
        for (int i = blockIdx.x * 512 + tid; i < TT / 4; i += gridDim.x * 512) z1[i] = float4{0.f, 0.f, 0.f, 0.f};
      }
      if (blockIdx.x == 0 && tid < 64) {
        float wq = fabsf(a.in[3][tid]), w1 = fabsf(a.in[4][64 + tid]), w2 = fabsf(a.in[4][128 + tid]);
#pragma unroll
        for (int o = 32; o >= 1; o >>= 1) { wq = fmaxf(wq, __shfl_xor(wq, o)); w1 = fmaxf(w1, __shfl_xor(w1, o)); w2 = fmaxf(w2, __shfl_xor(w2, o)); }
        if (tid == 0) {
          float* cs_ = reinterpret_cast<float*>(ws + O_CSH);
          cs_[0] = fminf(8.f * wq * w1, 40.f) * LOG2E_C; cs_[1] = fminf(8.f * wq * w2, 40.f) * LOG2E_C;
        }
      }
      {
        float* rc = reinterpret_cast<float*>(ws + O_ROPEC);
        float* rs = reinterpret_cast<float*>(ws + O_ROPES);
        for (int i = blockIdx.x * 512 + tid; i < 2048 * 32; i += gridDim.x * 512) {
          const int s = i >> 5, f = i & 31;
          const float inv = powf(10000.f, -(float)f / 32.f);
          const float ang = (float)s * inv;
          const double ad = (double)ang;
          const double nrev = rint(ad * 0.15915494309189535);
          const float rr = (float)(ad - nrev * 6.283185307179586);
          rc[i] = __cosf(rr); rs[i] = __sinf(rr);
        }
      }
      for (int item = blockIdx.x; item < 128; item += gridDim.x) {
        const int kq = item & 15, nb = (item >> 4) & 3, kv = item >> 6;
        const float* pe = a.in[kv ? 6 : 5];
        const float* w1 = a.in[kv ? 9 : 7];
        const int tx = tid & 63, ty = tid >> 6;
        float sacc_ = 0.f;
#pragma unroll
        for (int i = 0; i < 16; ++i) {
          const int k = kq * 128 + ty * 16 + i;
          sacc_ += pe[k] * w1[(size_t)k * 256 + nb * 64 + tx];
        }
        __syncthreads();
        smf[ty * 64 + tx] = sacc_;
        __syncthreads();
        if (ty == 0) {
          float t_ = 0.f;
#pragma unroll
          for (int j = 0; j < 8; ++j) t_ += smf[j * 64 + tx];
          reinterpret_cast<float*>(ws + O_B1P)[(kv * 16 + kq) * 256 + nb * 64 + tx] = t_;
        }
      }
      rmsnorm_rows(a.in[0], a.in[1], reinterpret_cast<bfu*>(ws + O_XN));
    }
    if (a0.ph_lo == 0x7fffffff) grid.sync();
    gbar(gb, 1u);
    if (PH_ON(1)) phase1(a0.ws, a0.in[3], a0.in[4], a0.out);
    if (REP_PH == 1) { grid.sync(); phase1(a0.ws, a0.in[3], a0.in[4], a0.out); }
    gbar(gb, 2u);
    if (PH_ON(2)) phase2(a0.ws, nullptr, nullptr, a0.out);
    if (REP_PH == 23) { grid.sync(); phase2(a0.ws, nullptr, nullptr, a0.out); }
    gbar(gb, 3u);
    if (PH_ON(3)) phase3(a0.ws, nullptr, nullptr, a0.out);
    if (REP_PH == 23) { grid.sync(); phase3(a0.ws, nullptr, nullptr, a0.out); }
    gbar(gb, 4u);
    if (PH_ON(4)) phase4(a0.ws, a0.in[11], nullptr, a0.out);
    if (REP_PH == 4) { grid.sync(); phase4(a0.ws, a0.in[11], nullptr, a0.out); }
    gbar(gb, 5u);
    if (PH_ON(5)) phase5(a0.ws, a0.in[0], nullptr, a0.out);
    if (REP_PH == 5) { grid.sync(); phase5(a0.ws, a0.in[0], nullptr, a0.out); }
    gbar(gb, 6u);
    if (PH_ON(7)) phase7(a0.ws, nullptr, nullptr, a0.out);
    if (REP_PH == 7) { grid.sync(); phase7(a0.ws, nullptr, nullptr, a0.out); }
    gbar(gb, 7u);
    if (PH_ON(8)) phase8(a0.ws, nullptr, nullptr, a0.out);
    if (REP_PH == 100) { for (int i = 0; i < 8; ++i) grid.sync(); }
    if (REP_PH == 101) { for (unsigned i = 0; i < 8; ++i) gbar(gb, 8u + i); }
  }
}

extern "C" void kernel_launch(void* const* d_in, const int* in_sizes, int n_in, void* d_out, int out_size, void* d_ws, size_t ws_size,
                              hipStream_t stream) {
  static int grid_blocks = 0;
  if (!grid_blocks) {
    int dev = 0, cus = 0, per_cu = 0;
    hipGetDevice(&dev);
    hipDeviceGetAttribute(&cus, hipDeviceAttributeMultiprocessorCount, dev);
    hipFuncSetAttribute((const void*)mega, hipFuncAttributeMaxDynamicSharedMemorySize, SMEM_BYTES);
    hipOccupancyMaxActiveBlocksPerMultiprocessor(&per_cu, (const void*)mega, 512, SMEM_BYTES);
    if (per_cu < 1) per_cu = 1;
    if (per_cu > 1) per_cu = 1;
    grid_blocks = cus * per_cu;
    if (ws_size < O_END) fprintf(stderr, "workspace too small: %zu < %zu\n", ws_size, (size_t)O_END);
  }
  Args a{};
  for (int i = 0; i < 16; ++i) a.in[i] = (const float*)d_in[i];
  a.out = (float*)d_out;
  a.ws = (unsigned char*)d_ws;
  a.ph_lo = 0; a.ph_hi = 9;
  (void)hipMemsetAsync((unsigned char*)d_ws + O_BAR, 0, 16384, stream);
  void* args[] = {&a};
  hipError_t e = hipLaunchCooperativeKernel((const void*)mega, dim3(grid_blocks), dim3(512), args, SMEM_BYTES, stream);
  if (e != hipSuccess) fprintf(stderr, "cooperative launch failed: %s (grid %d)\n", hipGetErrorString(e), grid_blocks);
}
```

```cpp
#include <hip/hip_runtime.h>
#include <hip/hip_bf16.h>
#include <hip/hip_cooperative_groups.h>
#include <cstdio>
namespace cg = cooperative_groups;

typedef unsigned short bfu;
using bf16x8 = __attribute__((ext_vector_type(8))) short;
using f32x4 = __attribute__((ext_vector_type(4))) float;
#define DI __device__ __forceinline__

constexpr int NB = 16, SQ = 2048, DM = 1024, TT = NB * SQ;
constexpr int DFF = 4096;
constexpr int NIN = 2840, NINP = 3072;
constexpr float EPSF = 1e-6f;
constexpr float LOG2E_C = 1.4426950408889634f;

constexpr size_t al256(size_t x) { return (x + 255) & ~(size_t)255; }
constexpr size_t O_WINT = 0;
constexpr size_t O_WOUTT = O_WINT + al256((size_t)NINP * 1024 * 2);
constexpr size_t O_WUPT = O_WOUTT + al256((size_t)1024 * 1024 * 2);
constexpr size_t O_WDOWNT = O_WUPT + al256((size_t)4096 * 1024 * 2);
constexpr size_t O_WK1T = O_WDOWNT + al256((size_t)1024 * 4096 * 2);
constexpr size_t O_WV1T = O_WK1T + al256((size_t)256 * 2048 * 2);
constexpr size_t O_WK2T = O_WV1T + al256((size_t)256 * 2048 * 2);
constexpr size_t O_WV2T = O_WK2T + al256((size_t)128 * 256 * 2);
constexpr size_t O_B1K = O_WV2T + al256((size_t)128 * 256 * 2);
constexpr size_t O_B1V = O_B1K + 1024;
constexpr size_t O_ROPEC = O_B1V + 1024;
constexpr size_t O_ROPES = O_ROPEC + (size_t)2048 * 32 * 4;
constexpr size_t O_XN = O_ROPES + (size_t)2048 * 32 * 4;
constexpr size_t O_QN = O_XN + (size_t)TT * 1024 * 2;
constexpr size_t O_KC = O_QN + (size_t)TT * 512 * 2;
constexpr size_t O_VC = O_KC + (size_t)TT * 128 * 2;
constexpr size_t O_KS = O_VC + (size_t)TT * 128 * 2;
constexpr size_t O_VST = O_KS + (size_t)TT * 128 * 2;
constexpr size_t O_KW = O_VST + (size_t)TT * 128 * 2;
constexpr size_t O_VWT = O_KW + (size_t)TT * 128 * 2;
constexpr size_t O_RQ = O_VWT + (size_t)TT * 128 * 2;
constexpr size_t O_RQX = O_RQ + (size_t)TT * 256 * 2;
constexpr size_t O_RK = O_RQX + (size_t)TT * 256 * 2;
constexpr size_t O_RKTZ = O_RK + (size_t)TT * 256 * 2;
constexpr size_t O_RVT = O_RKTZ + (size_t)TT * 256 * 2;
constexpr size_t O_RG = O_RVT + (size_t)TT * 512 * 2;
constexpr size_t O_GT = O_RG + (size_t)TT * 512 * 2;
constexpr size_t O_MIX = O_GT + (size_t)TT * 24 * 4;
constexpr size_t O_HK = O_MIX + (size_t)TT * 1024 * 2;
constexpr size_t O_HV = O_HK + (size_t)4096 * 256 * 2;
constexpr size_t O_KCMP = O_HV + (size_t)4096 * 256 * 2;
constexpr size_t O_VCMPT = O_KCMP + (size_t)32 * 128 * 64 * 2;
constexpr size_t O_KVT = O_VCMPT + (size_t)32 * 128 * 64 * 2;
constexpr size_t O_ONSA = O_KVT + (size_t)1024 * 128 * 64 * 4;
constexpr size_t O_END = O_ONSA + (size_t)TT * 512 * 4;
constexpr size_t O_HACC = O_ONSA;
constexpr size_t O_SS2 = O_ONSA + (size_t)40 * 1024 * 1024;
constexpr size_t O_B1P = O_ONSA + (size_t)44 * 1024 * 1024;
constexpr size_t O_BAR = O_ONSA + (size_t)45 * 1024 * 1024;
constexpr size_t O_STATE = O_ONSA + (size_t)48 * 1024 * 1024;
constexpr size_t O_CSH = O_B1P + 65536;
constexpr size_t O_ACT = O_QN;
static_assert(O_ACT + (size_t)TT * 4096 * 2 <= O_END, "act overlay");
static_assert(O_END <= (size_t)536870912, "ws budget");

struct Args {
  const float* in[16];
  float* out;
  unsigned char* ws;
  int ph_lo, ph_hi;
};

DI int get_tid() { int t = threadIdx.x; asm volatile("" : "+v"(t)); return t; }
typedef __bf16 bf16v2 __attribute__((ext_vector_type(2)));
typedef float f32v2 __attribute__((ext_vector_type(2)));
DI bfu f2bf(float x) { return __builtin_bit_cast(bfu, (__bf16)x); }
DI float bf2f(bfu v) { return __uint_as_float(((unsigned)v) << 16); }
DI unsigned pack2(float a, float b) { f32v2 v = {a, b}; return __builtin_bit_cast(unsigned, __builtin_convertvector(v, bf16v2)); }
DI void store4bf(bfu* dst, float a, float b, float c, float d) {
  uint2 v; v.x = pack2(a, b); v.y = pack2(c, d);
  *reinterpret_cast<uint2*>(dst) = v;
}
DI void store_pair16(bfu* rowp, int g, uint2 c0, uint2 c1) {
  const bool odd = (g & 1) != 0;
  const uint2 send = odd ? c0 : c1;
  uint2 recv; recv.x = __shfl_xor(send.x, 16); recv.y = __shfl_xor(send.y, 16);
  uint4 o;
  if (!odd) { o.x = c0.x; o.y = c0.y; o.z = recv.x; o.w = recv.y; }
  else { o.x = recv.x; o.y = recv.y; o.z = c1.x; o.w = c1.y; }
  *reinterpret_cast<uint4*>(rowp + (odd ? (12 + 4 * g) : (4 * g))) = o;
}
DI uint2 pack4(float a, float b, float c, float d) { uint2 v; v.x = pack2(a, b); v.y = pack2(c, d); return v; }
DI float fmax_fast(float a, float b) { float r; asm("v_max_f32 %0, %1, %2" : "=v"(r) : "v"(a), "v"(b)); return r; }
DI float fmax3_fast(float a, float b, float c) { float r; asm("v_max3_f32 %0, %1, %2, %3" : "=v"(r) : "v"(a), "v"(b), "v"(c)); return r; }
DI float wave_sum(float v) {
#pragma unroll
  for (int o = 32; o >= 1; o >>= 1) v += __shfl_xor(v, o);
  return v;
}
DI float siluf(float x) { return x * __builtin_amdgcn_rcpf(1.f + __expf(-x)); }
DI float sigmf(float x) { return __builtin_amdgcn_rcpf(1.f + __expf(-x)); }
DI float ret_log2gamma(int h) { return log2f(1.f - exp2f(-5.f - (float)h)); }

constexpr int LSTR = 64;
constexpr int RSTR_K = 72;
DI int swz(int row, int chunk) { return row * 64 + ((chunk ^ ((row >> 1) & 7)) << 3); }
constexpr int LTILE = 128 * LSTR;
constexpr int SMEM_BYTES = 100352 + 32768;

struct ARowPlain {
  const bfu* base; size_t ld;
  DI const bfu* operator()(int r) const { return base + (size_t)r * ld; }
};
struct ARowCmp {
  const bfu* base;
  DI const bfu* operator()(int r) const { int bg = r >> 7, c = r & 127; c = c > 126 ? 126 : c; return base + ((size_t)bg * 2048 + (size_t)c * 16) * 64; }
};

struct BRowClamp64 {
  const bfu* base; size_t ld;
  DI const bfu* operator()(int r) const { return base + (size_t)(r & 63) * ld; }
};
struct ARowClamp128 {
  const bfu* base; size_t ld;
  DI const bfu* operator()(int r) const { return base + (size_t)(r & 127) * ld; }
};
DI uint4 a_f32_bias_silu(const bfu* p, const float* bias) {
  float4 x0 = *reinterpret_cast<const float4*>(p), x1 = *reinterpret_cast<const float4*>(p + 8);
#pragma unroll
  for (int ks = 1; ks < 4; ++ks) {
    const bfu* q = p + (size_t)ks * 2 * 4096 * 256 * 2;
    const float4 y0 = *reinterpret_cast<const float4*>(q), y1 = *reinterpret_cast<const float4*>(q + 8);
    x0.x += y0.x; x0.y += y0.y; x0.z += y0.z; x0.w += y0.w; x1.x += y1.x; x1.y += y1.y; x1.z += y1.z; x1.w += y1.w;
  }
  const float4 b0 = *reinterpret_cast<const float4*>(bias), b1 = *reinterpret_cast<const float4*>(bias + 4);
  uint4 r;
  r.x = pack2(siluf(x0.x + b0.x), siluf(x0.y + b0.y)); r.y = pack2(siluf(x0.z + b0.z), siluf(x0.w + b0.w));
  r.z = pack2(siluf(x1.x + b1.x), siluf(x1.y + b1.y)); r.w = pack2(siluf(x1.z + b1.z), siluf(x1.w + b1.w));
  return r;
}
template <int MT, int AMODE = 0, class ARow, class BRow, class Epi>
DI void gemm_tile(const ARow& arow, const BRow& brow, int K, int m0, int n0, Epi& epi, bfu* smem, const float* abias = nullptr) {
  constexpr int BN = (MT == 4) ? 128 : 256;
  constexpr int NBL = BN / 64;
  constexpr int STAGE = (256 + BN) * LSTR;
  const int tid = get_tid(), lane = tid & 63, wid = __builtin_amdgcn_readfirstlane(tid >> 6);
  const int wr = (MT == 4) ? (wid >> 1) : (wid >> 2), wc = (MT == 4) ? (wid & 1) : (wid & 3);
  const int arow0 = wr * (16 * MT), bcol0 = wc * 64;
  const int c = lane & 15, g = lane >> 4;
  const int lrow = tid >> 3, lcc = tid & 7;
  const int lsw = swz(lrow, lcc);
  const int rsw0 = ((g ^ (c >> 1)) << 3), rsw1 = (((4 + g) ^ (c >> 1)) << 3);
  const bfu* ap[4]; const bfu* bp[NBL];
#pragma unroll
  for (int i = 0; i < 4; ++i) ap[i] = arow(m0 + lrow + 64 * i) + lcc * 8 * (AMODE ? 2 : 1);
  const float* abp = abias + lcc * 8;
#pragma unroll
  for (int i = 0; i < NBL; ++i) bp[i] = brow(n0 + lrow + 64 * i) + lcc * 8;
  f32x4 acc[MT / 4][4][4];
#pragma unroll
  for (int h = 0; h < MT / 4; ++h)
#pragma unroll
    for (int m = 0; m < 4; ++m)
#pragma unroll
      for (int n = 0; n < 4; ++n) acc[h][m][n] = f32x4{0.f, 0.f, 0.f, 0.f};
  uint4 ra0, ra1, ra2, ra3, rb0, rb1, rb2, rb3;
  const int nk = K / 64;
#define G_LOAD(KO) { if (AMODE == 0) { ra0 = *reinterpret_cast<const uint4*>(ap[0] + (KO)); ra1 = *reinterpret_cast<const uint4*>(ap[1] + (KO)); \
    ra2 = *reinterpret_cast<const uint4*>(ap[2] + (KO)); ra3 = *reinterpret_cast<const uint4*>(ap[3] + (KO)); } else { \
    ra0 = a_f32_bias_silu(ap[0] + 2 * (KO), abp + (KO)); ra1 = a_f32_bias_silu(ap[1] + 2 * (KO), abp + (KO)); \
    ra2 = a_f32_bias_silu(ap[2] + 2 * (KO), abp + (KO)); ra3 = a_f32_bias_silu(ap[3] + 2 * (KO), abp + (KO)); } \
    rb0 = *reinterpret_cast<const uint4*>(bp[0] + (KO)); rb1 = *reinterpret_cast<const uint4*>(bp[1] + (KO)); \
    if (NBL == 4) { rb2 = *reinterpret_cast<const uint4*>(bp[NBL - 2] + (KO)); rb3 = *reinterpret_cast<const uint4*>(bp[NBL - 1] + (KO)); } }
#define G_STORE(SA, SB) { *reinterpret_cast<uint4*>((SA) + lsw) = ra0; *reinterpret_cast<uint4*>((SA) + lsw + 64 * LSTR) = ra1; \
    *reinterpret_cast<uint4*>((SA) + lsw + 128 * LSTR) = ra2; *reinterpret_cast<uint4*>((SA) + lsw + 192 * LSTR) = ra3; \
    *reinterpret_cast<uint4*>((SB) + lsw) = rb0; *reinterpret_cast<uint4*>((SB) + lsw + 64 * LSTR) = rb1; \
    if (NBL == 4) { *reinterpret_cast<uint4*>((SB) + lsw + 128 * LSTR) = rb2; *reinterpret_cast<uint4*>((SB) + lsw + 192 * LSTR) = rb3; } }
  G_LOAD(0)
  G_STORE(smem, smem + 256 * LSTR)
  __syncthreads();
  for (int kt = 0; kt < nk; ++kt) {
    const int cur = kt & 1;
    if (kt + 1 < nk) G_LOAD((kt + 1) * 64)
    __builtin_amdgcn_sched_barrier(0);
    const bfu* sA = smem + cur * STAGE;
    const bfu* sB = sA + 256 * LSTR;
#pragma unroll
    for (int ks = 0; ks < 2; ++ks) {
      bf16x8 af[MT], bfr[4];
#pragma unroll
      for (int m = 0; m < MT; ++m) af[m] = *reinterpret_cast<const bf16x8*>(sA + (arow0 + 16 * m + c) * LSTR + (ks ? rsw1 : rsw0));
#pragma unroll
      for (int n = 0; n < 4; ++n) bfr[n] = *reinterpret_cast<const bf16x8*>(sB + (bcol0 + 16 * n + c) * LSTR + (ks ? rsw1 : rsw0));
#pragma unroll
      for (int m = 0; m < MT; ++m)
#pragma unroll
        for (int n = 0; n < 4; ++n) acc[m >> 2][m & 3][n] = __builtin_amdgcn_mfma_f32_16x16x32_bf16(bfr[n], af[m], acc[m >> 2][m & 3][n], 0, 0, 0);
    }
    __builtin_amdgcn_sched_barrier(0);
    if (kt + 1 < nk) { bfu* dA = smem + (cur ^ 1) * STAGE; G_STORE(dA, dA + 256 * LSTR) }
    __syncthreads();
  }
#undef G_LOAD
#undef G_STORE
#pragma unroll
  for (int h = 0; h < MT / 4; ++h) epi(m0 + arow0 + 64 * h, n0 + bcol0, acc[h]);
}

constexpr int G8_BK = 64, G8_HALF = 128, G8_HT = G8_HALF * G8_BK;
DI int g8_lds_byte(int r, int c) {
  int st = (r >> 4) * 2 + (c >> 5), rr = r & 15, cc = c & 31, ob = rr * 64 + cc * 2;
  return st * 1024 + (ob ^ (((ob >> 9) & 1) << 5));
}
DI void g8_stage_rc(int b, int& R, int& C) {
  int st = b / 1024, sb = b % 1024, swz_ = sb ^ (((sb >> 9) & 1) << 5);
  R = (st >> 1) * 16 + swz_ / 64; C = (st & 1) * 32 + (swz_ % 64) / 2;
}
template <int HEADS = 0, class Epi>
DI void gemm8p_tile(const bfu* __restrict__ A, const bfu* __restrict__ Bt, int K, int brow, int bcol, Epi& epi) {
  extern __shared__ __attribute__((aligned(16))) bfu g8shm[];
#define G8_SA(b, h) (g8shm + ((b) * 2 + (h)) * G8_HT)
#define G8_SB(b, h) (g8shm + (4 + (b) * 2 + (h)) * G8_HT)
#define G8_STAGE(P, BASE, br, kt) do { const char* _ub = (const char*)(BASE) + 2 * ((long)(br) * K + (long)(kt) * G8_BK); \
      __builtin_amdgcn_global_load_lds((const unsigned*)(_ub + voff0), \
        (__attribute__((address_space(3))) unsigned*)((__attribute__((address_space(3))) char*)(P) + tb16), 16, 0, 0); \
      __builtin_amdgcn_global_load_lds((const unsigned*)(_ub + voff1), \
        (__attribute__((address_space(3))) unsigned*)((__attribute__((address_space(3))) char*)(P) + tb16 + 8192), 16, 0, 0); } while (0)
#define G8_LDA(dst, b, h) for (int m = 0; m < 4; ++m) for (int k = 0; k < 2; ++k) \
    dst[m][k] = *reinterpret_cast<const bf16x8*>((const char*)G8_SA(b, h) + g8_lds_byte(wr * 64 + m * 16 + fr, k * 32 + fq * 8))
#define G8_LDB(dst, b, h) for (int n = 0; n < 2; ++n) for (int k = 0; k < 2; ++k) \
    dst[n][k] = *reinterpret_cast<const bf16x8*>((const char*)G8_SB(b, h) + g8_lds_byte(wc * 32 + n * 16 + fr, k * 32 + fq * 8))
#define G8_MMA(ai, bj, At_, Bt_) do { __builtin_amdgcn_s_setprio(1); \
    for (int m = 0; m < 4; ++m) for (int n = 0; n < 2; ++n) for (int k = 0; k < 2; ++k) \
      acc[ai][bj][m][n] = __builtin_amdgcn_mfma_f32_16x16x32_bf16(Bt_[n][k], At_[m][k], acc[ai][bj][m][n], 0, 0, 0); \
    __builtin_amdgcn_s_setprio(0); } while (0)
#define G8_WAIT_V(n) asm volatile("s_waitcnt vmcnt(" #n ")" ::: "memory")
#define G8_WAIT_L(n) asm volatile("s_waitcnt lgkmcnt(" #n ")" ::: "memory")
#define G8_BAR __builtin_amdgcn_s_barrier()
#define G8_SCHED __builtin_amdgcn_sched_barrier(0)
  const int tid8 = get_tid();
  const int wid = __builtin_amdgcn_readfirstlane(tid8 >> 6), lane = tid8 & 63, wr = wid >> 2, wc = wid & 3, fr = lane & 15, fq = lane >> 4;
  const int tb16 = tid8 * 16;
  unsigned voff0, voff1;
  { int r_, c_; g8_stage_rc(tb16, r_, c_); voff0 = 2u * ((unsigned)r_ * (unsigned)K + (unsigned)c_);
    g8_stage_rc(tb16 + 8192, r_, c_); voff1 = 2u * ((unsigned)r_ * (unsigned)K + (unsigned)c_); }
  f32x4 acc[2][2][4][2];
#pragma unroll
  for (int a_ = 0; a_ < 2; ++a_)
#pragma unroll
    for (int b_ = 0; b_ < 2; ++b_)
#pragma unroll
      for (int m = 0; m < 4; ++m)
#pragma unroll
        for (int n = 0; n < 2; ++n) acc[a_][b_][m][n] = f32x4{0.f, 0.f, 0.f, 0.f};
  bf16x8 At[4][2], B0[2][2], B1[2][2];
  const int nt = K / G8_BK;
  G8_WAIT_V(0);
  if (HEADS) { G8_WAIT_L(0); G8_BAR; }
  G8_STAGE(G8_SB(0, 0), Bt, bcol, 0); G8_STAGE(G8_SA(0, 0), A, brow, 0);
  G8_STAGE(G8_SB(0, 1), Bt, bcol + G8_HALF, 0); G8_STAGE(G8_SA(0, 1), A, brow + G8_HALF, 0);
  if (wr == 1) G8_BAR;
  G8_WAIT_V(4); G8_BAR;
  G8_STAGE(G8_SB(1, 0), Bt, bcol, 1); G8_STAGE(G8_SA(1, 0), A, brow, 1); G8_STAGE(G8_SB(1, 1), Bt, bcol + G8_HALF, 1);
  G8_WAIT_V(6); G8_BAR;
  for (int t = 0; t < nt - 2; t += 2) {
    G8_LDB(B0, 0, 0); G8_SCHED; G8_LDA(At, 0, 0); G8_STAGE(G8_SA(1, 1), A, brow + G8_HALF, t + 1);
    G8_WAIT_L(8); G8_BAR; G8_WAIT_L(0); G8_MMA(0, 0, At, B0); G8_BAR; G8_SCHED;
    G8_LDB(B1, 0, 1); G8_STAGE(G8_SB(0, 0), Bt, bcol, t + 2);
    G8_BAR; G8_WAIT_L(0); G8_MMA(0, 1, At, B1); G8_BAR;
    G8_LDA(At, 0, 1); G8_STAGE(G8_SA(0, 0), A, brow, t + 2);
    G8_BAR; G8_WAIT_L(0); G8_MMA(1, 0, At, B0); G8_BAR; G8_SCHED;
    G8_STAGE(G8_SB(0, 1), Bt, bcol + G8_HALF, t + 2);
    G8_WAIT_V(6); G8_BAR; G8_MMA(1, 1, At, B1); G8_BAR;
    G8_LDB(B0, 1, 0); G8_SCHED; G8_LDA(At, 1, 0); G8_STAGE(G8_SA(0, 1), A, brow + G8_HALF, t + 2);
    G8_WAIT_L(8); G8_BAR; G8_WAIT_L(0); G8_MMA(0, 0, At, B0); G8_BAR; G8_SCHED;
    G8_LDB(B1, 1, 1); G8_STAGE(G8_SB(1, 0), Bt, bcol, t + 3);
    G8_BAR; G8_WAIT_L(0); G8_MMA(0, 1, At, B1); G8_BAR;
    G8_LDA(At, 1, 1); G8_STAGE(G8_SA(1, 0), A, brow, t + 3);
    G8_BAR; G8_WAIT_L(0); G8_MMA(1, 0, At, B0); G8_BAR; G8_SCHED;
    G8_STAGE(G8_SB(1, 1), Bt, bcol + G8_HALF, t + 3);
    G8_WAIT_V(6); G8_BAR; G8_MMA(1, 1, At, B1); G8_BAR;
  }
  epi.pre(brow + wr * 64);
  { G8_LDB(B0, 0, 0); G8_LDA(At, 0, 0); G8_STAGE(G8_SA(1, 1), A, brow + G8_HALF, nt - 1);
    G8_BAR; G8_WAIT_L(0); G8_MMA(0, 0, At, B0); G8_BAR;
    G8_LDB(B1, 0, 1); G8_BAR; G8_WAIT_L(0); G8_MMA(0, 1, At, B1); G8_BAR;
    G8_LDA(At, 0, 1); G8_WAIT_V(4); G8_BAR; G8_WAIT_L(0); G8_MMA(1, 0, At, B0); G8_MMA(1, 1, At, B1); G8_BAR; }
  { G8_LDB(B0, 1, 0); G8_LDA(At, 1, 0); G8_WAIT_V(2); G8_BAR; G8_WAIT_L(0); G8_MMA(0, 0, At, B0); G8_BAR;
    G8_LDB(B1, 1, 1); G8_WAIT_V(0); G8_BAR; G8_WAIT_L(0); G8_MMA(0, 1, At, B1); G8_BAR;
    G8_LDA(At, 1, 1); G8_BAR; G8_WAIT_L(0); G8_MMA(1, 0, At, B0); G8_MMA(1, 1, At, B1); G8_BAR; }
  if (wr == 0) G8_BAR;
  if constexpr (HEADS != 0) {
    f32x4* park = reinterpret_cast<f32x4*>(g8shm) + (size_t)wid * 1024 + lane;
#pragma unroll
    for (int m = 0; m < 4; ++m) { park[(4 * m + 0) * 64] = acc[1][0][m][0]; park[(4 * m + 1) * 64] = acc[1][0][m][1]; park[(4 * m + 2) * 64] = acc[1][1][m][0]; park[(4 * m + 3) * 64] = acc[1][1][m][1]; }
    {
      f32x4 hacc[4][4];
#pragma unroll
      for (int m = 0; m < 4; ++m) { hacc[m][0] = acc[0][0][m][0]; hacc[m][1] = acc[0][0][m][1]; hacc[m][2] = acc[0][1][m][0]; hacc[m][3] = acc[0][1][m][1]; }
      epi(brow + wr * 64, bcol + wc * 64, hacc);
    }
    __builtin_amdgcn_sched_barrier(0);
    {
      f32x4 hacc[4][4];
#pragma unroll
      for (int m = 0; m < 4; ++m)
#pragma unroll
        for (int n = 0; n < 4; ++n) hacc[m][n] = park[(4 * m + n) * 64];
      epi(brow + G8_HALF + wr * 64, bcol + wc * 64, hacc);
    }
  } else {
#pragma unroll
    for (int ai = 0; ai < 2; ++ai)
#pragma unroll
      for (int bj = 0; bj < 2; ++bj) epi(brow + ai * G8_HALF + wr * 64, bcol + bj * G8_HALF + wc * 32, acc[ai][bj]);
  }
#undef G8_SA
#undef G8_SB
#undef G8_STAGE
#undef G8_LDA
#undef G8_LDB
#undef G8_MMA
#undef G8_WAIT_V
#undef G8_WAIT_L
#undef G8_BAR
#undef G8_SCHED
}

struct EpiProj {
  unsigned char* ws; const float* qnw; const float* knw;
  DI void pre(int) {}
  DI void operator()(int row0, int col0, f32x4 (&acc)[4][4]) const {
    const int lane = get_tid() & 63, c = lane & 15, g = lane >> 4;
    const int b = row0 >> 11, s0 = row0 & 2047;
    if (col0 >= 2880) return;
    if (col0 == 2816) {
      float* dst = reinterpret_cast<float*>(ws + O_GT);
#pragma unroll
      for (int m = 0; m < 4; ++m) {
        const size_t t = (size_t)row0 + 16 * m + c;
#pragma unroll
        for (int n = 0; n < 2; ++n) {
          const int f = 16 * n + 4 * g;
          if (f < 24) {
            float4 v; v.x = sigmf(acc[m][n][0]); v.y = sigmf(acc[m][n][1]); v.z = sigmf(acc[m][n][2]); v.w = sigmf(acc[m][n][3]);
            *reinterpret_cast<float4*>(dst + t * 24 + f) = v;
          }
        }
      }
      return;
    }
    int seg, hh;
    if (col0 < 512) { seg = 0; hh = col0 >> 6; }
    else if (col0 < 1280) { seg = 1 + ((col0 - 512) >> 7); hh = ((col0 - 512) & 127) >> 6; }
    else if (col0 < 1536) { seg = 7; hh = (col0 - 1280) >> 6; }
    else if (col0 < 1792) { seg = 8; hh = (col0 - 1536) >> 6; }
    else if (col0 < 2304) { seg = 9; hh = (col0 - 1792) >> 7; }
    else { seg = 10; hh = 0; }
    const bool do_norm = (seg == 0 || seg == 1 || seg == 3 || seg == 5);
    const bool do_rope = do_norm || seg == 7 || seg == 8;
    bfu* dstA = nullptr; size_t strideA = 64;
    bfu* dstA2 = nullptr;
    bfu* dstB = nullptr;
    const size_t bg64 = ((size_t)(b * 2 + hh) * 2048) * 64;
    const size_t bh64 = ((size_t)(b * 4 + hh) * 2048) * 64;
    if (seg == 0) dstA = reinterpret_cast<bfu*>(ws + O_QN) + ((size_t)(b * 8 + hh) * 2048 + s0) * 64;
    else if (seg == 1) dstA = reinterpret_cast<bfu*>(ws + O_KC) + bg64 + (size_t)s0 * 64;
    else if (seg == 2) dstA = reinterpret_cast<bfu*>(ws + O_VC) + bg64 + (size_t)s0 * 64;
    else if (seg == 3) dstA = reinterpret_cast<bfu*>(ws + O_KS) + bg64 + (size_t)s0 * 64;
    else if (seg == 4) dstB = reinterpret_cast<bfu*>(ws + O_VST) + bg64 + s0;
    else if (seg == 5) dstA = reinterpret_cast<bfu*>(ws + O_KW) + bg64 + (size_t)s0 * 64;
    else if (seg == 6) dstB = reinterpret_cast<bfu*>(ws + O_VWT) + bg64 + s0;
    else if (seg == 7) { dstA = reinterpret_cast<bfu*>(ws + O_RQ) + bh64 + (size_t)s0 * 64; dstA2 = reinterpret_cast<bfu*>(ws + O_RQX) + bh64 + (size_t)s0 * 64; }
    else if (seg == 8) { dstA = reinterpret_cast<bfu*>(ws + O_RK) + bh64 + (size_t)s0 * 64; dstB = reinterpret_cast<bfu*>(ws + O_RKTZ) + bh64 + s0; }
    else if (seg == 9) dstB = reinterpret_cast<bfu*>(ws + O_RVT) + ((size_t)(b * 4 + hh) * 128 + ((col0 - 1792) & 127)) * 2048 + s0;
    else { dstA = reinterpret_cast<bfu*>(ws + O_RG) + (size_t)row0 * 512 + (col0 - 2304); strideA = 512; }

    if (do_norm) {
      const float* nw = (seg == 0) ? qnw : (knw + ((seg - 1) >> 1) * 64);
#pragma unroll
      for (int m = 0; m < 4; ++m) {
        float ss = 0.f;
#pragma unroll
        for (int n = 0; n < 4; ++n)
#pragma unroll
          for (int j = 0; j < 4; ++j) ss += acc[m][n][j] * acc[m][n][j];
        ss += __shfl_xor(ss, 16); ss += __shfl_xor(ss, 32);
        const float r = rsqrtf(ss * (1.f / 64.f) + EPSF);
#pragma unroll
        for (int n = 0; n < 4; ++n) {
          const float4 w = *reinterpret_cast<const float4*>(nw + 16 * n + 4 * g);
          acc[m][n][0] *= r * w.x; acc[m][n][1] *= r * w.y; acc[m][n][2] *= r * w.z; acc[m][n][3] *= r * w.w;
        }
        __builtin_amdgcn_sched_barrier(0);
      }
    }
    if (do_rope) {
      const float* ropeC = reinterpret_cast<const float*>(ws + O_ROPEC);
      const float* ropeS = reinterpret_cast<const float*>(ws + O_ROPES);
      const float mul = (seg == 0) ? 0.125f * LOG2E_C : ((seg == 8) ? 0.125f : 1.f);
#pragma unroll
      for (int m = 0; m < 4; ++m) {
        const int s = s0 + 16 * m + c;
#pragma unroll
        for (int n = 0; n < 2; ++n) {
          const unsigned ro = (unsigned)(s * 32 + 16 * n + 4 * g);
          float4 cs = *reinterpret_cast<const float4*>(ropeC + ro);
          float4 sn = *reinterpret_cast<const float4*>(ropeS + ro);
          cs.x *= mul; cs.y *= mul; cs.z *= mul; cs.w *= mul; sn.x *= mul; sn.y *= mul; sn.z *= mul; sn.w *= mul;
          float x1, x2;
          x1 = acc[m][n][0]; x2 = acc[m][n + 2][0]; acc[m][n][0] = x1 * cs.x - x2 * sn.x; acc[m][n + 2][0] = x2 * cs.x + x1 * sn.x;
          x1 = acc[m][n][1]; x2 = acc[m][n + 2][1]; acc[m][n][1] = x1 * cs.y - x2 * sn.y; acc[m][n + 2][1] = x2 * cs.y + x1 * sn.y;
          x1 = acc[m][n][2]; x2 = acc[m][n + 2][2]; acc[m][n][2] = x1 * cs.z - x2 * sn.z; acc[m][n + 2][2] = x2 * cs.z + x1 * sn.z;
          x1 = acc[m][n][3]; x2 = acc[m][n + 2][3]; acc[m][n][3] = x1 * cs.w - x2 * sn.w; acc[m][n + 2][3] = x2 * cs.w + x1 * sn.w;
        }
        __builtin_amdgcn_sched_barrier(0);
      }
    }
    if (seg == 10) {
#pragma unroll
      for (int m = 0; m < 4; ++m)
#pragma unroll
        for (int n = 0; n < 4; ++n)
#pragma unroll
          for (int j = 0; j < 4; ++j) acc[m][n][j] = siluf(acc[m][n][j]);
    }
    if (dstA) {
#pragma unroll
      for (int m = 0; m < 4; ++m) {
        bfu* d = dstA + (size_t)(16 * m + c) * strideA;
        store_pair16(d, g, pack4(acc[m][0][0], acc[m][0][1], acc[m][0][2], acc[m][0][3]), pack4(acc[m][1][0], acc[m][1][1], acc[m][1][2], acc[m][1][3]));
        store_pair16(d + 32, g, pack4(acc[m][2][0], acc[m][2][1], acc[m][2][2], acc[m][2][3]), pack4(acc[m][3][0], acc[m][3][1], acc[m][3][2], acc[m][3][3]));
        __builtin_amdgcn_sched_barrier(0);
      }
    }
    if (seg == 7 || seg == 8) {
      const float l2g = ret_log2gamma(hh);
#pragma unroll
      for (int m = 0; m < 4; ++m) {
        const int i = (s0 + 16 * m + c) & 127;
        const float f = exp2f(l2g * (float)((seg == 7) ? (i + 1) : (127 - i)));
#pragma unroll
        for (int n = 0; n < 4; ++n)
#pragma unroll
          for (int j = 0; j < 4; ++j) acc[m][n][j] *= f;
      }
    }
    if (dstA2) {
#pragma unroll
      for (int m = 0; m < 4; ++m) {
        bfu* d = dstA2 + (size_t)(16 * m + c) * 64;
        store_pair16(d, g, pack4(acc[m][0][0], acc[m][0][1], acc[m][0][2], acc[m][0][3]), pack4(acc[m][1][0], acc[m][1][1], acc[m][1][2], acc[m][1][3]));
        store_pair16(d + 32, g, pack4(acc[m][2][0], acc[m][2][1], acc[m][2][2], acc[m][2][3]), pack4(acc[m][3][0], acc[m][3][1], acc[m][3][2], acc[m][3][3]));
        __builtin_amdgcn_sched_barrier(0);
      }
    }
    if (dstB) {
#pragma unroll
      for (int m = 0; m < 4; ++m) {
        bfu* d = dstB + (size_t)(4 * g) * 2048 + 16 * m + c;
#pragma unroll
        for (int n = 0; n < 4; ++n)
#pragma unroll
          for (int j = 0; j < 4; ++j) d[(size_t)(16 * n + j) * 2048] = f2bf(acc[m][n][j]);
        __builtin_amdgcn_sched_barrier(0);
      }
    }
  }
};

struct EpiCmp1 {
  float* H;
  DI void operator()(int row0, int col0, f32x4 (&acc)[4][4]) const {
    const int lane = get_tid() & 63, c = lane & 15, g = lane >> 4;
#pragma unroll
    for (int m = 0; m < 4; ++m) {
      float* hr = H + ((size_t)row0 + 16 * m + c) * 256 + col0 + 4 * g;
#pragma unroll
      for (int n = 0; n < 4; ++n) {
        float4 v; v.x = acc[m][n][0]; v.y = acc[m][n][1]; v.z = acc[m][n][2]; v.w = acc[m][n][3];
        *reinterpret_cast<float4*>(hr + 16 * n) = v;
      }
    }
  }
};

struct EpiCmp2 {
  bfu* dst; int kv;
  DI void operator()(int row0, int col0, f32x4 (&acc)[4][4]) const {
    if (col0 != 0) return;
    const int lane = get_tid() & 63, c = lane & 15, g = lane >> 4;
#pragma unroll
    for (int m = 0; m < 4; ++m) {
      const int r = row0 + 16 * m + c, bg = r >> 7, ci = r & 127;
      const float z = (ci == 127) ? 0.f : 1.f;
#pragma unroll
      for (int n = 0; n < 4; ++n) {
        const int d = 16 * n + 4 * g;
        if (kv == 0) store4bf(dst + ((size_t)bg * 128 + ci) * 64 + d, acc[m][n][0] * z, acc[m][n][1] * z, acc[m][n][2] * z, acc[m][n][3] * z);
        else {
#pragma unroll
          for (int j = 0; j < 4; ++j) dst[((size_t)bg * 64 + d + j) * 128 + ci] = f2bf(acc[m][n][j] * z);
        }
      }
    }
  }
};

struct EpiOut {
  const float* x; float* out;
  DI void operator()(int row0, int col0, f32x4 (&acc)[4][4]) const {
    const int lane = get_tid() & 63, c = lane & 15, g = lane >> 4;
#pragma unroll
    for (int m = 0; m < 4; ++m) {
      const size_t t = (size_t)row0 + 16 * m + c;
#pragma unroll
      for (int n = 0; n < 4; ++n) {
        const size_t o = t * 1024 + col0 + 16 * n + 4 * g;
        float4 xv = *reinterpret_cast<const float4*>(x + o);
        xv.x += acc[m][n][0]; xv.y += acc[m][n][1]; xv.z += acc[m][n][2]; xv.w += acc[m][n][3];
        *reinterpret_cast<float4*>(out + o) = xv;
      }
    }
  }
};

struct EpiUp {
  bfu* act;
  DI void operator()(int row0, int col0, f32x4 (&acc)[4][4]) const {
    const int lane = get_tid() & 63, c = lane & 15, g = lane >> 4;
#pragma unroll
    for (int m = 0; m < 4; ++m) {
      const size_t t = (size_t)row0 + 16 * m + c;
#pragma unroll
      for (int n = 0; n < 4; ++n) {
        float v[4];
#pragma unroll
        for (int j = 0; j < 4; ++j) { const float r = fmaxf(acc[m][n][j], 0.f); v[j] = r * r; }
        store4bf(act + t * 4096 + col0 + 16 * n + 4 * g, v[0], v[1], v[2], v[3]);
      }
    }
  }
};

struct EpiDown {
  float* out;
  DI void operator()(int row0, int col0, f32x4 (&acc)[4][4]) const {
    const int lane = get_tid() & 63, c = lane & 15, g = lane >> 4;
#pragma unroll
    for (int m = 0; m < 4; ++m) {
      const size_t t = (size_t)row0 + 16 * m + c;
#pragma unroll
      for (int n = 0; n < 4; ++n) {
        float* o = out + t * 1024 + col0 + 16 * n + 4 * g;
        float4 xv = *reinterpret_cast<const float4*>(o);
        xv.x += acc[m][n][0]; xv.y += acc[m][n][1]; xv.z += acc[m][n][2]; xv.w += acc[m][n][3];
        *reinterpret_cast<float4*>(o) = xv;
      }
    }
  }
};


struct EpiOut2 {
  const float* x; float* out; bfu* hb; float* ss2;
  DI void pre(int) {}
  DI void operator()(int row0, int col0, f32x4 (&acc)[4][2]) const {
    const int lane = get_tid() & 63, c = lane & 15, g = lane >> 4;
#pragma unroll
    for (int m = 0; m < 4; ++m) {
      const size_t t = (size_t)row0 + 16 * m + c;
      float ss = 0.f;
      uint2 hch[2];
#pragma unroll
      for (int n = 0; n < 2; ++n) {
        const size_t o = t * 1024 + col0 + 16 * n + 4 * g;
        float4 xv = *reinterpret_cast<const float4*>(x + o);
        xv.x += acc[m][n][0]; xv.y += acc[m][n][1]; xv.z += acc[m][n][2]; xv.w += acc[m][n][3];
        hch[n] = pack4(xv.x, xv.y, xv.z, xv.w);
        ss += xv.x * xv.x + xv.y * xv.y + xv.z * xv.z + xv.w * xv.w;
      }
      store_pair16(hb + t * 1024 + col0, g, hch[0], hch[1]);
      ss += __shfl_xor(ss, 16); ss += __shfl_xor(ss, 32);
      if (g == 0) unsafeAtomicAdd(ss2 + t, ss);
    }
  }
};
struct EpiUp2 {
  bfu* act; const float* ss2;
  float ssv[2][4]; int base;
  DI void pre(int row0a) {
    const int c = get_tid() & 15;
    base = row0a;
#pragma unroll
    for (int ai = 0; ai < 2; ++ai)
#pragma unroll
      for (int m = 0; m < 4; ++m) ssv[ai][m] = ss2[(size_t)row0a + 128 * ai + 16 * m + c];
  }
  DI void operator()(int row0, int col0, f32x4 (&acc)[4][2]) const {
    const int lane = get_tid() & 63, c = lane & 15, g = lane >> 4;
    const bool hi = (row0 != base);
#pragma unroll
    for (int m = 0; m < 4; ++m) {
      const size_t t = (size_t)row0 + 16 * m + c;
      const float r2 = rsqrtf((hi ? ssv[1][m] : ssv[0][m]) * (1.f / 1024.f) + EPSF);
      uint2 ch[2];
#pragma unroll
      for (int n = 0; n < 2; ++n) {
        float v[4];
#pragma unroll
        for (int j = 0; j < 4; ++j) { const float r = fmaxf(acc[m][n][j] * r2, 0.f); v[j] = r * r; }
        ch[n] = pack4(v[0], v[1], v[2], v[3]);
      }
      store_pair16(act + t * 4096 + col0, g, ch[0], ch[1]);
    }
  }
};
struct EpiDown2 {
  float* out; const bfu* hb;
  DI void pre(int) {}
  DI void operator()(int row0, int col0, f32x4 (&acc)[4][2]) const {
    const int lane = get_tid() & 63, c = lane & 15, g = lane >> 4;
#pragma unroll
    for (int m = 0; m < 4; ++m) {
      const size_t t = (size_t)row0 + 16 * m + c;
#pragma unroll
      for (int n = 0; n < 2; ++n) {
        const size_t o = t * 1024 + col0 + 16 * n + 4 * g;
        const uint2 hv = *reinterpret_cast<const uint2*>(hb + o);
        float4 xv;
        xv.x = __uint_as_float(hv.x << 16) + acc[m][n][0]; xv.y = __uint_as_float(hv.x & 0xffff0000u) + acc[m][n][1];
        xv.z = __uint_as_float(hv.y << 16) + acc[m][n][2]; xv.w = __uint_as_float(hv.y & 0xffff0000u) + acc[m][n][3];
        *reinterpret_cast<float4*>(out + o) = xv;
      }
    }
  }
};

DI bool tile_map(int it, int nM, int nN, int& pm, int& pn) {
  const int nwg = nM * nN, xcd = blockIdx.x & 7, slot = blockIdx.x >> 3, per = gridDim.x >> 3;
  const int q = nwg >> 3;
  const int loc = it * per + slot;
  if (slot >= per || loc >= q) return false;
  const int id = xcd * q + loc;
  const int nig = 8 * nN, gid = id / nig, fm = gid * 8;
  const int gsz = (nM - fm < 8) ? (nM - fm) : 8;
  pm = fm + (id % nig) % gsz; pn = (id % nig) / gsz;
  return true;
}

DI int win_src_col(int n) {
  if (n < 1280) return n;
  if (n < 2816) return n + 24;
  if (n < 2840) return n - 2816 + 1280;
  return -1;
}
DI void tconv(const float* __restrict__ src, int K, int N, bfu* __restrict__ dst, int Np, int mode, float* tl, const float* kscale = nullptr) {
  const int tid = get_tid(), tx = tid & 63, ty = tid >> 6;
  const int ntk = K / 64, ntn = Np / 64, ntile = ntk * ntn;
  float v[8];
  auto load_tile = [&](int tile) {
    const int k0 = (tile % ntk) * 64, n0 = (tile / ntk) * 64;
    const int np = n0 + tx;
    int col = np;
    if (mode == 1) {
      const int r = np & 255;
      col = win_src_col((np & ~255) + ((r >> 5) & 3) * 64 + (r >> 7) * 32 + (r & 31));
    } else if (np >= N) col = -1;
#pragma unroll
    for (int i = 0; i < 8; ++i) {
      const int k = ty + 8 * i;
      float x = (col >= 0) ? src[(size_t)(k0 + k) * N + col] : 0.f;
      if (kscale) x *= kscale[k0 + k];
      v[i] = x;
    }
  };
  int tile = blockIdx.x;
  if (tile < ntile) load_tile(tile);
  for (; tile < ntile; tile += gridDim.x) {
    const int k0 = (tile % ntk) * 64, n0 = (tile / ntk) * 64;
#pragma unroll
    for (int i = 0; i < 8; ++i) tl[(ty + 8 * i) * 65 + tx] = v[i];
    __syncthreads();
    if (tile + (int)gridDim.x < ntile) load_tile(tile + gridDim.x);
#pragma unroll
    for (int i = 0; i < 8; ++i) {
      const int n = ty + 8 * i;
      dst[(size_t)(n0 + n) * K + k0 + tx] = f2bf(tl[tx * 65 + n]);
    }
    __syncthreads();
  }
}

DI void rmsnorm_rows(const float* src, const float* __restrict__ w, bfu* __restrict__ dst) {
  const int tidr = get_tid();
  const int lane = tidr & 63, wid = tidr >> 6;
  float4 ww[4];
#pragma unroll
  for (int i = 0; i < 4; ++i) ww[i] = *reinterpret_cast<const float4*>(w + i * 256 + lane * 4);
  for (int row0 = (blockIdx.x * 8 + wid) * 4; row0 < TT; row0 += gridDim.x * 8 * 4) {
    float4 v[4][4];
#pragma unroll
    for (int r = 0; r < 4; ++r)
#pragma unroll
      for (int i = 0; i < 4; ++i) v[r][i] = *reinterpret_cast<const float4*>(src + (size_t)(row0 + r) * 1024 + i * 256 + lane * 4);
#pragma unroll
    for (int r = 0; r < 4; ++r) {
      float ss = 0.f;
#pragma unroll
      for (int i = 0; i < 4; ++i) ss += v[r][i].x * v[r][i].x + v[r][i].y * v[r][i].y + v[r][i].z * v[r][i].z + v[r][i].w * v[r][i].w;
      ss = wave_sum(ss);
      const float sc = rsqrtf(ss * (1.f / 1024.f) + EPSF);
#pragma unroll
      for (int i = 0; i < 4; ++i)
        store4bf(dst + (size_t)(row0 + r) * 1024 + i * 256 + lane * 4, v[r][i].x * sc * ww[i].x, v[r][i].y * sc * ww[i].y, v[r][i].z * sc * ww[i].z, v[r][i].w * sc * ww[i].w);
    }
  }
}

constexpr float LOG2E = 1.4426950408889634f;
constexpr int KV_TILE = 64 * LSTR;
constexpr int NSA_OTOT_OFF = 8 * KV_TILE * 2;

DI void kv_gload(uint4& r0, uint4& r2, const bfu* K, const bfu* VT, int vstride) {
  const int id0 = get_tid();
  r0 = *reinterpret_cast<const uint4*>(K + (id0 >> 3) * 64 + (id0 & 7) * 8);
  r2 = *reinterpret_cast<const uint4*>(VT + (size_t)(id0 >> 3) * vstride + (id0 & 7) * 8);
}
DI void kv_sstore(const uint4& r0, const uint4& r2, bfu* buf) {
  const int id0 = get_tid();
  const int o = swz(id0 >> 3, id0 & 7);
  *reinterpret_cast<uint4*>(buf + o) = r0;
  *reinterpret_cast<uint4*>(buf + KV_TILE + o) = r2;
}
DI void st_compute(f32x4 (&sacc)[4][2], const bf16x8 (&qf)[2][2], const bfu* Kt, int c, int g, float cinit0, float cinit1) {
  const f32x4 ci[2] = {f32x4{cinit0, cinit0, cinit0, cinit0}, f32x4{cinit1, cinit1, cinit1, cinit1}};
#pragma unroll
  for (int mk = 0; mk < 4; ++mk) {
    const bf16x8 kf0 = *reinterpret_cast<const bf16x8*>(Kt + (16 * mk + c) * LSTR + (((0 + g) ^ (c >> 1)) << 3));
    const bf16x8 kf1 = *reinterpret_cast<const bf16x8*>(Kt + (16 * mk + c) * LSTR + (((4 + g) ^ (c >> 1)) << 3));
#pragma unroll
    for (int n = 0; n < 2; ++n) {
      sacc[mk][n] = __builtin_amdgcn_mfma_f32_16x16x32_bf16(kf0, qf[n][0], ci[n], 0, 0, 0);
      sacc[mk][n] = __builtin_amdgcn_mfma_f32_16x16x32_bf16(kf1, qf[n][1], sacc[mk][n], 0, 0, 0);
    }
  }
}
DI void pv_compute(f32x4 (&oacc)[4][2], const f32x4 (&p)[4][2], const bfu* VTt, int c, int g) {
#pragma unroll
  for (int kp = 0; kp < 2; ++kp) {
    bf16x8 pf[2];
#pragma unroll
    for (int n = 0; n < 2; ++n) {
      uint4 u;
      u.x = pack2(p[2 * kp][n][0], p[2 * kp][n][1]); u.y = pack2(p[2 * kp][n][2], p[2 * kp][n][3]);
      u.z = pack2(p[2 * kp + 1][n][0], p[2 * kp + 1][n][1]); u.w = pack2(p[2 * kp + 1][n][2], p[2 * kp + 1][n][3]);
      pf[n] = __builtin_bit_cast(bf16x8, u);
    }
#pragma unroll
    for (int md = 0; md < 4; ++md) {
      const bfu* vrow = VTt + (16 * md + c) * LSTR + (g & 1) * 4;
      const int ch0 = 4 * kp + (g >> 1);
      const uint2 lo = *reinterpret_cast<const uint2*>(vrow + ((ch0 ^ (c >> 1)) << 3));
      const uint2 hi = *reinterpret_cast<const uint2*>(vrow + (((ch0 + 2) ^ (c >> 1)) << 3));
      uint4 u; u.x = lo.x; u.y = lo.y; u.z = hi.x; u.w = hi.y;
      const bf16x8 vf = __builtin_bit_cast(bf16x8, u);
#pragma unroll
      for (int n = 0; n < 2; ++n) oacc[md][n] = __builtin_amdgcn_mfma_f32_16x16x32_bf16(vf, pf[n], oacc[md][n], 0, 0, 0);
    }
  }
}
DI void pv_compute_l(f32x4 (&oacc)[4][2], f32x4 (&lacc)[2], const f32x4 (&p)[4][2], const bfu* VTt, int c, int g, const bf16x8& onesf) {
#pragma unroll
  for (int kp = 0; kp < 2; ++kp) {
    bf16x8 pf[2];
#pragma unroll
    for (int n = 0; n < 2; ++n) {
      uint4 u;
      u.x = pack2(p[2 * kp][n][0], p[2 * kp][n][1]); u.y = pack2(p[2 * kp][n][2], p[2 * kp][n][3]);
      u.z = pack2(p[2 * kp + 1][n][0], p[2 * kp + 1][n][1]); u.w = pack2(p[2 * kp + 1][n][2], p[2 * kp + 1][n][3]);
      pf[n] = __builtin_bit_cast(bf16x8, u);
    }
#pragma unroll
    for (int n = 0; n < 2; ++n) lacc[n] = __builtin_amdgcn_mfma_f32_16x16x32_bf16(onesf, pf[n], lacc[n], 0, 0, 0);
#pragma unroll
    for (int md = 0; md < 4; ++md) {
      const bfu* vrow = VTt + (16 * md + c) * LSTR + (g & 1) * 4;
      const int ch0 = 4 * kp + (g >> 1);
      const uint2 lo = *reinterpret_cast<const uint2*>(vrow + ((ch0 ^ (c >> 1)) << 3));
      const uint2 hi = *reinterpret_cast<const uint2*>(vrow + (((ch0 + 2) ^ (c >> 1)) << 3));
      uint4 u; u.x = lo.x; u.y = lo.y; u.z = hi.x; u.w = hi.y;
      const bf16x8 vf = __builtin_bit_cast(bf16x8, u);
#pragma unroll
      for (int n = 0; n < 2; ++n) oacc[md][n] = __builtin_amdgcn_mfma_f32_16x16x32_bf16(vf, pf[n], oacc[md][n], 0, 0, 0);
    }
  }
}

template <int MODE>
DI void nsa_mask_edge(f32x4 (&sacc)[4][2], int jt, int qt, int ql0, int c, int g) {
  const bool diag = (jt == qt);
  const bool lowedge = (MODE == 1) && (jt == qt - 4);
  if (diag || lowedge) {
    int qlv = ql0 + c, klv = 4 * g;
    asm volatile("" : "+v"(qlv), "+v"(klv));
    const int dlt = qlv - klv;
#pragma unroll
    for (int mk = 0; mk < 4; ++mk)
#pragma unroll
      for (int n = 0; n < 2; ++n)
#pragma unroll
        for (int j = 0; j < 4; ++j) {
          const int off = 16 * mk + j - 16 * n;
          const bool v = diag ? (off <= dlt) : (off > dlt);
          sacc[mk][n][j] = v ? sacc[mk][n][j] : -1e30f;
        }
  }
}

template <int MODE, int PRE = 0>
DI void nsa_branch(f32x4 (&oacc)[4][2], float (&lrun)[2], const bf16x8 (&qf)[2][2], const bfu* Kb, const bfu* VTb,
                   unsigned tilemask, int qt, int ql0, const unsigned (&selb)[2], bfu* smem, int c, int g, float cshift,
                   uint4 p0 = uint4{0, 0, 0, 0}, uint4 p1 = uint4{0, 0, 0, 0}, uint4 p2 = uint4{0, 0, 0, 0}, uint4 p3 = uint4{0, 0, 0, 0}) {
  float mrun[2];
#pragma unroll
  for (int n = 0; n < 2; ++n) { mrun[n] = -1e30f; lrun[n] = 0.f; }
#pragma unroll
  for (int md = 0; md < 4; ++md)
#pragma unroll
    for (int n = 0; n < 2; ++n) oacc[md][n] = f32x4{0.f, 0.f, 0.f, 0.f};
  f32x4 lacc[2] = {f32x4{0.f, 0.f, 0.f, 0.f}, f32x4{0.f, 0.f, 0.f, 0.f}};
  bf16x8 onesf;
  { const short o_ = (c == 0) ? (short)0x3F80 : (short)0; onesf = bf16x8{o_, o_, o_, o_, o_, o_, o_, o_}; }
  uint4 r0, r1, r2, r3;
  unsigned tm = __builtin_amdgcn_readfirstlane(tilemask);
  int ja = __ffs(tm) - 1; tm &= tm - 1;
  int jb = -1;
  if (tm) { jb = __ffs(tm) - 1; tm &= tm - 1; }
  if (PRE) { r0 = p0; r1 = p1; r2 = p2; r3 = p3; }
  else {
    kv_gload(r0, r1, Kb + (size_t)ja * 64 * 64, VTb + ja * 64, 2048);
    if (jb >= 0) kv_gload(r2, r3, Kb + (size_t)jb * 64 * 64, VTb + jb * 64, 2048);
  }
  kv_sstore(r0, r1, smem);
  if (jb >= 0) kv_sstore(r2, r3, smem + 2 * KV_TILE);
  __syncthreads();
  int cur = 0;
  while (true) {
    int na = -1, nb = -1;
    if (tm) { na = __ffs(tm) - 1; tm &= tm - 1; }
    if (tm) { nb = __ffs(tm) - 1; tm &= tm - 1; }
    if (na >= 0) kv_gload(r0, r1, Kb + (size_t)na * 64 * 64, VTb + na * 64, 2048);
    if (nb >= 0) kv_gload(r2, r3, Kb + (size_t)nb * 64 * 64, VTb + nb * 64, 2048);
    __builtin_amdgcn_sched_barrier(0);
    const bfu* St = smem + cur * 4 * KV_TILE;
    f32x4 sA[4][2], sB[4][2];
    float tmax[2];
#pragma unroll
    for (int n = 0; n < 2; ++n) tmax[n] = -1e30f;
    {
      const float i0 = (MODE == 0 && !((selb[0] >> ja) & 1u)) ? -1e30f : -cshift, i1 = (MODE == 0 && !((selb[1] >> ja) & 1u)) ? -1e30f : -cshift;
      st_compute(sA, qf, St, c, g, i0, i1);
      nsa_mask_edge<MODE>(sA, ja, qt, ql0, c, g);
    }
    if (jb >= 0) {
      const float i0 = (MODE == 0 && !((selb[0] >> jb) & 1u)) ? -1e30f : -cshift, i1 = (MODE == 0 && !((selb[1] >> jb) & 1u)) ? -1e30f : -cshift;
      st_compute(sB, qf, St + 2 * KV_TILE, c, g, i0, i1);
      nsa_mask_edge<MODE>(sB, jb, qt, ql0, c, g);
    }
#pragma unroll
    for (int mk = 0; mk < 4; ++mk)
#pragma unroll
      for (int n = 0; n < 2; ++n)
#pragma unroll
        for (int j = 0; j < 4; ++j) sA[mk][n][j] = __builtin_amdgcn_exp2f(sA[mk][n][j]);
    __builtin_amdgcn_sched_barrier(0);
    if (na >= 0) kv_sstore(r0, r1, smem + (cur ^ 1) * 4 * KV_TILE);
    if (nb >= 0) kv_sstore(r2, r3, smem + (cur ^ 1) * 4 * KV_TILE + 2 * KV_TILE);
    __builtin_amdgcn_sched_barrier(0);
    pv_compute_l(oacc, lacc, sA, St + KV_TILE, c, g, onesf);
    if (jb >= 0) {
#pragma unroll
      for (int mk = 0; mk < 4; ++mk)
#pragma unroll
        for (int n = 0; n < 2; ++n)
#pragma unroll
          for (int j = 0; j < 4; ++j) sB[mk][n][j] = __builtin_amdgcn_exp2f(sB[mk][n][j]);
      pv_compute_l(oacc, lacc, sB, St + 3 * KV_TILE, c, g, onesf);
    }
    __syncthreads();
    if (na < 0) break;
    ja = na; jb = nb; cur ^= 1;
  }
#pragma unroll
  for (int n = 0; n < 2; ++n) lrun[n] = __shfl(lacc[n][0], c);
}

DI void nsa_item(unsigned char* ws, int item, unsigned char* smem_raw, bool load_cmp) {
  const int tid = get_tid(), lane = tid & 63, w = __builtin_amdgcn_readfirstlane(tid >> 6), c = lane & 15, g = lane >> 4;
  const int hw = w & 3, hq = w >> 2, ql0 = 32 * hq;
  int qt;
  { const int k = item >> 5; qt = (k < 16) ? (31 - k) : (k - 16); }
  const int bg = item & 31;
  const int b = bg >> 1, gk = bg & 1, h = gk * 4 + hw;
  bfu* smem = reinterpret_cast<bfu*>(smem_raw);
  uint2* otot = reinterpret_cast<uint2*>(smem_raw + NSA_OTOT_OFF) + (size_t)(w * 8) * 64 + lane;
  float* part = reinterpret_cast<float*>(smem_raw + NSA_OTOT_OFF);
  float* score = reinterpret_cast<float*>(smem_raw);
  unsigned* selm = reinterpret_cast<unsigned*>(smem_raw + 64 * 33 * 4);
  const int sq0 = 64 * qt + ql0;
  const bfu* Qb = reinterpret_cast<const bfu*>(ws + O_QN) + ((size_t)(b * 8 + h) * 2048 + sq0) * 64;
  const bfu* Kcmp = reinterpret_cast<const bfu*>(ws + O_KCMP) + (size_t)bg * 128 * 64;
  const bfu* VcmpT = reinterpret_cast<const bfu*>(ws + O_VCMPT) + (size_t)bg * 64 * 128;
  const float* Gt = reinterpret_cast<const float*>(ws + O_GT);
  const size_t t0 = (size_t)b * 2048 + sq0;

  bf16x8 qf[2][2];
#pragma unroll
  for (int n = 0; n < 2; ++n)
#pragma unroll
    for (int ks = 0; ks < 2; ++ks) qf[n][ks] = *reinterpret_cast<const bf16x8*>(Qb + (16 * n + c) * 64 + 32 * ks + 8 * g);

  const bfu* Kw = reinterpret_cast<const bfu*>(ws + O_KW) + (size_t)bg * 2048 * 64;
  const bfu* VwT = reinterpret_cast<const bfu*>(ws + O_VWT) + (size_t)bg * 64 * 2048;
  unsigned wm = 0u;
  for (int j = (qt >= 4 ? qt - 4 : 0); j <= qt; ++j) wm |= 1u << j;
  f32x4 oacc[4][2];
  bfu* cmpb = reinterpret_cast<bfu*>(smem_raw + 100352);
  {
    if (load_cmp) {
      uint4 r0, r2;
      kv_gload(r0, r2, Kcmp, VcmpT, 128); kv_sstore(r0, r2, cmpb);
      kv_gload(r0, r2, Kcmp + 64 * 64, VcmpT + 64, 128); kv_sstore(r0, r2, cmpb + 2 * KV_TILE);
    }
    const bool t1 = (qt >= 16);
    __syncthreads();
    f32x4 s0[4][2], s1[4][2];
    st_compute(s0, qf, cmpb, c, g, 0.f, 0.f);
    if (t1) st_compute(s1, qf, cmpb + 2 * KV_TILE, c, g, 0.f, 0.f);
    else {
#pragma unroll
      for (int mk = 0; mk < 4; ++mk)
#pragma unroll
        for (int n = 0; n < 2; ++n) s1[mk][n] = f32x4{0.f, 0.f, 0.f, 0.f};
    }
    int ncv[2]; float mx[2], ls[2];
#pragma unroll
    for (int n = 0; n < 2; ++n) { const int qp = sq0 + 16 * n + c; ncv[n] = (qp >= 31) ? ((qp - 31) / 16 + 1) : 0; mx[n] = -1e30f; ls[n] = 0.f; }
#pragma unroll
    for (int mk = 0; mk < 4; ++mk)
#pragma unroll
      for (int n = 0; n < 2; ++n)
#pragma unroll
        for (int j = 0; j < 4; ++j) {
          const int ci = 16 * mk + 4 * g + j;
          const float v0 = (ci < ncv[n]) ? s0[mk][n][j] : -1e30f;
          const float v1 = (ci + 64 < ncv[n]) ? s1[mk][n][j] : -1e30f;
          s0[mk][n][j] = v0; s1[mk][n][j] = v1;
          mx[n] = fmax_fast(mx[n], fmax_fast(v0, v1));
        }
#pragma unroll
    for (int n = 0; n < 2; ++n) { float t = mx[n]; t = fmax_fast(t, __shfl_xor(t, 16)); t = fmax_fast(t, __shfl_xor(t, 32)); mx[n] = t; }
#pragma unroll
    for (int mk = 0; mk < 4; ++mk)
#pragma unroll
      for (int n = 0; n < 2; ++n)
#pragma unroll
        for (int j = 0; j < 4; ++j) {
          const float mxb = fmax_fast(mx[n], -1e20f);
          const float p0 = __builtin_amdgcn_exp2f(s0[mk][n][j] - mxb);
          const float p1 = __builtin_amdgcn_exp2f(s1[mk][n][j] - mxb);
          s0[mk][n][j] = p0; s1[mk][n][j] = p1; ls[n] += p0 + p1;
        }
#pragma unroll
    for (int n = 0; n < 2; ++n) {
      float l = ls[n]; l += __shfl_xor(l, 16); l += __shfl_xor(l, 32);
      const float inv = (l > 0.f) ? 1.f / l : 0.f;
#pragma unroll
      for (int mk = 0; mk < 4; ++mk)
#pragma unroll
        for (int j = 0; j < 4; ++j) { s0[mk][n][j] *= inv; s1[mk][n][j] *= inv; }
    }
#pragma unroll
    for (int n = 0; n < 2; ++n) {
      float prev3 = 0.f;
#pragma unroll
      for (int tt = 0; tt < 2; ++tt)
#pragma unroll
        for (int mk = 0; mk < 4; ++mk) {
          const f32x4 pv = tt ? s1[mk][n] : s0[mk][n];
          const float sum4 = pv[0] + pv[1] + pv[2] + pv[3];
          const float send = (g == 3) ? prev3 : pv[3];
          const float recv = __shfl(send, (lane + 48) & 63);
          part[(hw * 64 + ql0 + 16 * n + c) * 33 + 16 * tt + 4 * mk + g] = sum4 + recv;
          prev3 = pv[3];
        }
    }
#pragma unroll
    for (int md = 0; md < 4; ++md)
#pragma unroll
      for (int n = 0; n < 2; ++n) oacc[md][n] = f32x4{0.f, 0.f, 0.f, 0.f};
    pv_compute(oacc, s0, cmpb + KV_TILE, c, g);
    if (t1) pv_compute(oacc, s1, cmpb + 3 * KV_TILE, c, g);
#pragma unroll
    for (int n = 0; n < 2; ++n) {
      const float g0 = Gt[(t0 + 16 * n + c) * 24 + h];
#pragma unroll
      for (int md = 0; md < 4; ++md) { oacc[md][n][0] *= g0; oacc[md][n][1] *= g0; oacc[md][n][2] *= g0; oacc[md][n][3] *= g0; }
    }
  }
  __syncthreads();
  {
    const int q = tid >> 3, p8 = tid & 7;
    if (tid == 0) selm[64] = 0u;
#pragma unroll
    for (int jj = 0; jj < 4; ++jj) {
      const int j = p8 * 4 + jj;
      const float v = part[(0 * 64 + q) * 33 + j] + part[(1 * 64 + q) * 33 + j] + part[(2 * 64 + q) * 33 + j] + part[(3 * 64 + q) * 33 + j];
      const bool forced = (j == 0) || (j == qt) || (j == qt - 1);
      score[q * 33 + j] = forced ? 1.0e4f : ((j <= qt) ? v : -1.f);
    }
    __syncthreads();
    float mine[4]; int rank[4];
#pragma unroll
    for (int jj = 0; jj < 4; ++jj) { mine[jj] = score[q * 33 + p8 * 4 + jj]; rank[jj] = 0; }
#pragma unroll 8
    for (int j2 = 0; j2 < 32; ++j2) {
      const float o = score[q * 33 + j2];
      const int d2 = j2 - p8 * 4;
#pragma unroll
      for (int jj = 0; jj < 4; ++jj) rank[jj] += (int)(o > mine[jj]) + (int)((o == mine[jj]) & (d2 < jj));
    }
    unsigned bits = 0u;
#pragma unroll
    for (int jj = 0; jj < 4; ++jj) if (rank[jj] < 8) bits |= 1u << (p8 * 4 + jj);
    bits |= __shfl_xor(bits, 1); bits |= __shfl_xor(bits, 2); bits |= __shfl_xor(bits, 4);
    if (p8 == 0) { selm[q] = bits; atomicOr(&selm[64], bits); }
    __syncthreads();
  }
  unsigned selb[2];
#pragma unroll
  for (int n = 0; n < 2; ++n) selb[n] = selm[ql0 + 16 * n + c];
  const unsigned umask = selm[64] & ((qt == 31) ? 0xffffffffu : ((2u << qt) - 1u));
#pragma unroll
  for (int md = 0; md < 4; ++md)
#pragma unroll
    for (int n = 0; n < 2; ++n) {
      uint2 v; v.x = pack2(oacc[md][n][0], oacc[md][n][1]); v.y = pack2(oacc[md][n][2], oacc[md][n][3]);
      otot[(md * 2 + n) * 64] = v;
    }
  __syncthreads();
  float lrun[2];
  {
    const bfu* Ks = reinterpret_cast<const bfu*>(ws + O_KS) + (size_t)bg * 2048 * 64;
    const bfu* VsT = reinterpret_cast<const bfu*>(ws + O_VST) + (size_t)bg * 64 * 2048;
    nsa_branch<0>(oacc, lrun, qf, Ks, VsT, umask, qt, ql0, selb, smem, c, g, reinterpret_cast<const float*>(ws + O_CSH)[0]);
#pragma unroll
    for (int n = 0; n < 2; ++n) {
      const float g1 = Gt[(t0 + 16 * n + c) * 24 + 8 + h] / lrun[n];
#pragma unroll
      for (int md = 0; md < 4; ++md) {
        const uint2 v = otot[(md * 2 + n) * 64];
        const float o0 = __uint_as_float(v.x << 16) + g1 * oacc[md][n][0];
        const float o1 = __uint_as_float(v.x & 0xffff0000u) + g1 * oacc[md][n][1];
        const float o2 = __uint_as_float(v.y << 16) + g1 * oacc[md][n][2];
        const float o3 = __uint_as_float(v.y & 0xffff0000u) + g1 * oacc[md][n][3];
        uint2 u; u.x = pack2(o0, o1); u.y = pack2(o2, o3);
        otot[(md * 2 + n) * 64] = u;
      }
    }
  }
  {
    nsa_branch<1>(oacc, lrun, qf, Kw, VwT, wm, qt, ql0, selb, smem, c, g, reinterpret_cast<const float*>(ws + O_CSH)[1]);
    bfu* mix = reinterpret_cast<bfu*>(ws + O_MIX);
#pragma unroll
    for (int n = 0; n < 2; ++n) {
      const float g2 = Gt[(t0 + 16 * n + c) * 24 + 16 + h] / lrun[n];
      bfu* md_ = mix + (t0 + 16 * n + c) * 1024 + h * 64 + 4 * g;
#pragma unroll
      for (int md = 0; md < 4; ++md) {
        const uint2 v = otot[(md * 2 + n) * 64];
        const float o0 = __uint_as_float(v.x << 16) + g2 * oacc[md][n][0];
        const float o1 = __uint_as_float(v.x & 0xffff0000u) + g2 * oacc[md][n][1];
        const float o2 = __uint_as_float(v.y << 16) + g2 * oacc[md][n][2];
        const float o3 = __uint_as_float(v.y & 0xffff0000u) + g2 * oacc[md][n][3];
        store4bf(md_ + 16 * md, o0, o1, o2, o3);
      }
    }
  }
}

struct EpiKV {
  float* dst;
  DI void operator()(int row0, int col0, f32x4 (&acc)[4][4]) const {
    if (col0 != 0 || row0 >= 128) return;
    const int lane = get_tid() & 63, c = lane & 15, g = lane >> 4;
#pragma unroll
    for (int m = 0; m < 4; ++m)
#pragma unroll
      for (int n = 0; n < 4; ++n) {
        float4 v; v.x = acc[m][n][0]; v.y = acc[m][n][1]; v.z = acc[m][n][2]; v.w = acc[m][n][3];
        *reinterpret_cast<float4*>(dst + (size_t)(row0 + 16 * m + c) * 64 + 16 * n + 4 * g) = v;
      }
  }
};

constexpr int RSTR_V = 136;
DI void ret_item(const float* ret_norm_w, unsigned char* ws, int item, unsigned char* smem_raw) {
  const int tid = get_tid(), lane = tid & 63, w = __builtin_amdgcn_readfirstlane(tid >> 6), c = lane & 15, g = lane >> 4;
  const int bh = item >> 4, ch = item & 15, b = bh >> 2, h = bh & 3;
  bfu* Kt = reinterpret_cast<bfu*>(smem_raw);
  bfu* St = Kt + 128 * RSTR_K;
  bfu* VTt = St + 128 * RSTR_K;
  const float l2g = ret_log2gamma(h);
  {
    const bfu* Rk = reinterpret_cast<const bfu*>(ws + O_RK) + ((size_t)bh * 2048 + ch * 128) * 64;
#pragma unroll
    for (int i = 0; i < 2; ++i) {
      const int id = tid + 512 * i, row = id >> 3, cc = id & 7;
      *reinterpret_cast<uint4*>(Kt + row * RSTR_K + cc * 8) = *reinterpret_cast<const uint4*>(Rk + row * 64 + cc * 8);
    }
    const bfu* RvT = reinterpret_cast<const bfu*>(ws + O_RVT) + ((size_t)bh * 128) * 2048 + ch * 128;
#pragma unroll
    for (int i = 0; i < 4; ++i) {
      const int id = tid + 512 * i, row = id >> 4, cc = id & 15;
      *reinterpret_cast<uint4*>(VTt + row * RSTR_V + cc * 8) = *reinterpret_cast<const uint4*>(RvT + (size_t)row * 2048 + cc * 8);
    }
    const bfu* Sg = reinterpret_cast<const bfu*>(ws + O_STATE) + (size_t)item * 8192;
#pragma unroll
    for (int i = 0; i < 2; ++i) {
      const int id = tid + 512 * i, row = id >> 3, cc = id & 7;
      *reinterpret_cast<uint4*>(St + row * RSTR_K + cc * 8) = *reinterpret_cast<const uint4*>(Sg + row * 64 + cc * 8);
    }
  }
  __syncthreads();
  bf16x8 qf[2], qxf[2];
  {
    const bfu* Rq = reinterpret_cast<const bfu*>(ws + O_RQ) + ((size_t)bh * 2048 + ch * 128 + 16 * w) * 64;
    const bfu* Rqx = reinterpret_cast<const bfu*>(ws + O_RQX) + ((size_t)bh * 2048 + ch * 128 + 16 * w) * 64;
#pragma unroll
    for (int ks = 0; ks < 2; ++ks) {
      qf[ks] = *reinterpret_cast<const bf16x8*>(Rq + c * 64 + 32 * ks + 8 * g);
      qxf[ks] = *reinterpret_cast<const bf16x8*>(Rqx + c * 64 + 32 * ks + 8 * g);
    }
  }
  f32x4 sacc[8];
#pragma unroll
  for (int mk = 0; mk < 8; ++mk) {
    sacc[mk] = f32x4{0.f, 0.f, 0.f, 0.f};
    if (mk <= w) {
#pragma unroll
      for (int ks = 0; ks < 2; ++ks) {
        const bf16x8 kf = *reinterpret_cast<const bf16x8*>(Kt + (16 * mk + c) * RSTR_K + 32 * ks + 8 * g);
        sacc[mk] = __builtin_amdgcn_mfma_f32_16x16x32_bf16(kf, qf[ks], sacc[mk], 0, 0, 0);
      }
#pragma unroll
      for (int j = 0; j < 4; ++j) {
        const int d = (16 * w + c) - (16 * mk + 4 * g + j);
        sacc[mk][j] = (d >= 0) ? sacc[mk][j] * __builtin_amdgcn_exp2f(l2g * (float)d) : 0.f;
      }
    }
  }
  f32x4 oacc[8];
#pragma unroll
  for (int md = 0; md < 8; ++md) oacc[md] = f32x4{0.f, 0.f, 0.f, 0.f};
#pragma unroll
  for (int kp = 0; kp < 4; ++kp) {
    if (2 * kp <= w) {
      uint4 u;
      u.x = pack2(sacc[2 * kp][0], sacc[2 * kp][1]); u.y = pack2(sacc[2 * kp][2], sacc[2 * kp][3]);
      u.z = pack2(sacc[2 * kp + 1][0], sacc[2 * kp + 1][1]); u.w = pack2(sacc[2 * kp + 1][2], sacc[2 * kp + 1][3]);
      const bf16x8 pf = __builtin_bit_cast(bf16x8, u);
#pragma unroll
      for (int md = 0; md < 8; ++md) {
        const bfu* vp = VTt + (16 * md + c) * RSTR_V + 32 * kp + 4 * g;
        const uint2 lo = *reinterpret_cast<const uint2*>(vp);
        const uint2 hi = *reinterpret_cast<const uint2*>(vp + 16);
        uint4 uu; uu.x = lo.x; uu.y = lo.y; uu.z = hi.x; uu.w = hi.y;
        const bf16x8 vf = __builtin_bit_cast(bf16x8, uu);
        oacc[md] = __builtin_amdgcn_mfma_f32_16x16x32_bf16(vf, pf, oacc[md], 0, 0, 0);
      }
    }
  }
#pragma unroll
  for (int ks = 0; ks < 2; ++ks)
#pragma unroll
    for (int md = 0; md < 8; ++md) {
      const bf16x8 sf = *reinterpret_cast<const bf16x8*>(St + (16 * md + c) * RSTR_K + 32 * ks + 8 * g);
      oacc[md] = __builtin_amdgcn_mfma_f32_16x16x32_bf16(sf, qxf[ks], oacc[md], 0, 0, 0);
    }
  const float* rnw = ret_norm_w + h * 128;
  const bfu* Rg = reinterpret_cast<const bfu*>(ws + O_RG);
  bfu* mix = reinterpret_cast<bfu*>(ws + O_MIX);
  {
    float sm = 0.f;
#pragma unroll
    for (int md = 0; md < 8; ++md) sm += oacc[md][0] + oacc[md][1] + oacc[md][2] + oacc[md][3];
    sm += __shfl_xor(sm, 16); sm += __shfl_xor(sm, 32);
    const float mu = sm * (1.f / 128.f);
    float vs = 0.f;
#pragma unroll
    for (int md = 0; md < 8; ++md)
#pragma unroll
      for (int j = 0; j < 4; ++j) { const float d = oacc[md][j] - mu; oacc[md][j] = d; vs += d * d; }
    vs += __shfl_xor(vs, 16); vs += __shfl_xor(vs, 32);
    const float rs = rsqrtf(vs * (1.f / 128.f) + EPSF);
    const size_t t = (size_t)b * 2048 + ch * 128 + 16 * w + c;
#pragma unroll
    for (int md = 0; md < 8; ++md) {
      const int dv = 16 * md + 4 * g;
      const float4 wv = *reinterpret_cast<const float4*>(rnw + dv);
      const uint2 gg = *reinterpret_cast<const uint2*>(Rg + t * 512 + h * 128 + dv);
      const float o0 = oacc[md][0] * rs * wv.x * __uint_as_float(gg.x << 16);
      const float o1 = oacc[md][1] * rs * wv.y * __uint_as_float(gg.x & 0xffff0000u);
      const float o2 = oacc[md][2] * rs * wv.z * __uint_as_float(gg.y << 16);
      const float o3 = oacc[md][3] * rs * wv.w * __uint_as_float(gg.y & 0xffff0000u);
      store4bf(mix + t * 1024 + 512 + h * 128 + dv, o0, o1, o2, o3);
    }
  }
  __syncthreads();
}

constexpr int NPHASE = 9;
#ifndef ONLY_PH
#define ONLY_PH -1
#endif
#define PH_ON(k) (ONLY_PH < 0 || ONLY_PH == (k))
#ifndef REP_PH
#define REP_PH -1
#endif
#define PHASE_ARGS const Args& a = a0; unsigned char* ws = a0.ws;
DI void phase1(unsigned char* ws, const float* pa, const float* pb, float* out) {
  extern __shared__ __attribute__((aligned(16))) unsigned char smem_raw[];
  bfu* smem = reinterpret_cast<bfu*>(smem_raw);
      EpiProj epi{ws, pa, pb};
      const bfu* Am = reinterpret_cast<const bfu*>(ws + O_XN);
      const bfu* Bt = reinterpret_cast<const bfu*>(ws + O_WINT);
      for (int it = 0;; ++it) {
        int mt, nt; if (!tile_map(it, 128, 12, mt, nt)) break;
        gemm8p_tile<1>(Am, Bt, 1024, mt * 256, nt * 256, epi);
      }
}
DI void phase2(unsigned char* ws, const float* pa, const float* pb, float* out) {
  extern __shared__ __attribute__((aligned(16))) unsigned char smem_raw[];
  bfu* smem = reinterpret_cast<bfu*>(smem_raw);
      if (blockIdx.x == gridDim.x - 1) {
        const int t_ = get_tid();
        const float* bp_ = reinterpret_cast<const float*>(ws + O_B1P);
        const int kv = t_ >> 8, n = t_ & 255;
        float acc_ = 0.f;
#pragma unroll
        for (int kq = 0; kq < 16; ++kq) acc_ += bp_[(kv * 16 + kq) * 256 + n];
        reinterpret_cast<float*>(ws + (kv ? O_B1V : O_B1K))[n] = acc_;
      }
      for (int item = blockIdx.x; item < 256 + 1024; item += gridDim.x) {
        if (item < 256) {
          const int ks = item & 3, nt = (item >> 2) & 1, mt = (item >> 3) & 15, kv = item >> 7;
          EpiCmp1 epi{reinterpret_cast<float*>(ws + O_HACC) + (size_t)(ks * 2 + kv) * 4096 * 256};
          ARowCmp ar{reinterpret_cast<const bfu*>(ws + (kv ? O_VC : O_KC)) + ks * 512};
          gemm_tile<4>(ar, ARowPlain{reinterpret_cast<const bfu*>(ws + (kv ? O_WV1T : O_WK1T)) + ks * 512, 2048}, 512, mt * 256, nt * 128, epi, smem);
        } else {
          const int it = item - 256, bh = it >> 4, ch = it & 15;
          EpiKV epi{reinterpret_cast<float*>(ws + O_KVT) + (size_t)it * 8192};
          ARowClamp128 ar{reinterpret_cast<const bfu*>(ws + O_RVT) + (size_t)bh * 128 * 2048 + ch * 128, 2048};
          BRowClamp64 br{reinterpret_cast<const bfu*>(ws + O_RKTZ) + (size_t)bh * 64 * 2048 + ch * 128, 2048};
          gemm_tile<4>(ar, br, 128, 0, 0, epi, smem);
        }
      }
}
DI void phase3(unsigned char* ws, const float* pa, const float* pb, float* out) {
  extern __shared__ __attribute__((aligned(16))) unsigned char smem_raw[];
  bfu* smem = reinterpret_cast<bfu*>(smem_raw);
      for (int item = (int)gridDim.x - 1 - (int)blockIdx.x; item < 256; item += gridDim.x) {
        const int bh = item >> 2, q = item & 3, h = bh & 3;
        const int e = q * 2048 + get_tid() * 4;
        const float gC = exp2f(ret_log2gamma(h) * 128.f);
        const float* KVt = reinterpret_cast<const float*>(ws + O_KVT) + (size_t)(bh * 16) * 8192 + e;
        bfu* Sg = reinterpret_cast<bfu*>(ws + O_STATE) + (size_t)(bh * 16) * 8192 + e;
        float4 kvv[15];
#pragma unroll
        for (int cc = 0; cc < 15; ++cc) kvv[cc] = *reinterpret_cast<const float4*>(KVt + (size_t)cc * 8192);
        float4 st = {0.f, 0.f, 0.f, 0.f};
        store4bf(Sg, 0.f, 0.f, 0.f, 0.f);
#pragma unroll
        for (int cc = 0; cc < 15; ++cc) {
          st.x = st.x * gC + kvv[cc].x; st.y = st.y * gC + kvv[cc].y; st.z = st.z * gC + kvv[cc].z; st.w = st.w * gC + kvv[cc].w;
          store4bf(Sg + (size_t)(cc + 1) * 8192, st.x, st.y, st.z, st.w);
        }
      }
      for (int item = blockIdx.x; item < 32; item += gridDim.x) {
        const int kv = item >> 4, mt = item & 15;
        EpiCmp2 epi{reinterpret_cast<bfu*>(ws + (kv ? O_VCMPT : O_KCMP)), kv};
        ARowPlain ar{reinterpret_cast<const bfu*>(ws + O_HACC + (size_t)kv * 4096 * 256 * 4), 512};
        gemm_tile<4, 1>(ar, ARowPlain{reinterpret_cast<const bfu*>(ws + (kv ? O_WV2T : O_WK2T)), 256}, 256, mt * 256, 0, epi, smem,
                        reinterpret_cast<const float*>(ws + (kv ? O_B1V : O_B1K)));
      }
    }
DI void phase4(unsigned char* ws, const float* pa, const float* pb, float* out) {
  extern __shared__ __attribute__((aligned(16))) unsigned char smem_raw[];
  bfu* smem = reinterpret_cast<bfu*>(smem_raw);
      {
        int prev_bg = -1;
        for (int item = blockIdx.x; item < 1024; item += gridDim.x) { const int bg_ = item & 31; nsa_item(ws, item, smem_raw, bg_ != prev_bg); prev_bg = bg_; }
      }
      for (int item = blockIdx.x; item < 1024; item += gridDim.x) ret_item(pa, ws, item, smem_raw);
      if (REP_PH == 42) { for (int item = blockIdx.x; item < 1024; item += gridDim.x) ret_item(pa, ws, item, smem_raw); }
      if (REP_PH == 42) { for (int item = blockIdx.x; item < 1024; item += gridDim.x) ret_item(pa, ws, item, smem_raw); }
    }
DI void phase5(unsigned char* ws, const float* pa, const float* pb, float* out) {
  extern __shared__ __attribute__((aligned(16))) unsigned char smem_raw[];
  bfu* smem = reinterpret_cast<bfu*>(smem_raw);
      EpiOut2 epi{pa, out, reinterpret_cast<bfu*>(ws + O_XN), reinterpret_cast<float*>(ws + O_SS2)};
      const bfu* Am = reinterpret_cast<const bfu*>(ws + O_MIX);
      const bfu* Bt = reinterpret_cast<const bfu*>(ws + O_WOUTT);
      for (int it = 0;; ++it) {
        int mt, nt; if (!tile_map(it, 128, 4, mt, nt)) break;
        gemm8p_tile(Am, Bt, 1024, mt * 256, nt * 256, epi);
      }
    }
DI void phase6(unsigned char* ws, const float* pa, const float* pb, float* out) {
  extern __shared__ __attribute__((aligned(16))) unsigned char smem_raw[];
  bfu* smem = reinterpret_cast<bfu*>(smem_raw);
      rmsnorm_rows(out, pa, reinterpret_cast<bfu*>(ws + O_XN));
    }
DI void phase7(unsigned char* ws, const float* pa, const float* pb, float* out) {
  extern __shared__ __attribute__((aligned(16))) unsigned char smem_raw[];
  bfu* smem = reinterpret_cast<bfu*>(smem_raw);
      EpiUp2 epi{reinterpret_cast<bfu*>(ws + O_ACT), reinterpret_cast<const float*>(ws + O_SS2)};
      const bfu* Am = reinterpret_cast<const bfu*>(ws + O_XN);
      const bfu* Bt = reinterpret_cast<const bfu*>(ws + O_WUPT);
      for (int it = 0;; ++it) {
        int mt, nt; if (!tile_map(it, 128, 16, mt, nt)) break;
        gemm8p_tile(Am, Bt, 1024, mt * 256, nt * 256, epi);
      }
    }
DI void phase8(unsigned char* ws, const float* pa, const float* pb, float* out) {
  extern __shared__ __attribute__((aligned(16))) unsigned char smem_raw[];
  bfu* smem = reinterpret_cast<bfu*>(smem_raw);
      EpiDown2 epi{out, reinterpret_cast<const bfu*>(ws + O_XN)};
      const bfu* Am = reinterpret_cast<const bfu*>(ws + O_ACT);
      const bfu* Bt = reinterpret_cast<const bfu*>(ws + O_WDOWNT);
      for (int it = 0;; ++it) {
        int mt, nt; if (!tile_map(it, 128, 4, mt, nt)) break;
        gemm8p_tile(Am, Bt, 4096, mt * 256, nt * 256, epi);
      }
    }

struct GBar { unsigned* w; unsigned x, nloc, nx; };
DI unsigned gb_xcc_id() { return (unsigned)__builtin_amdgcn_s_getreg((3 << 11) | 20) & 0xFu; }
DI void gbar(GBar& b, unsigned k) {
  asm volatile("s_waitcnt vmcnt(0)" ::: "memory");
  __syncthreads();
  if (threadIdx.x == 0) {
    asm volatile("s_waitcnt vmcnt(0) lgkmcnt(0)" ::: "memory");
    if (b.nloc == 0u) {
      for (;;) {
        unsigned sum = 0u, cnt = 0u, mine = 0u;
#pragma unroll
        for (unsigned j = 0; j < 16; ++j) { const unsigned cc = __hip_atomic_load(b.w + 256 + 64 * j, __ATOMIC_RELAXED, __HIP_MEMORY_SCOPE_AGENT); sum += cc; cnt += (cc > 0u) ? 1u : 0u; mine = (j == b.x) ? cc : mine; }
        if (sum == gridDim.x) { b.nloc = mine; b.nx = cnt; break; }
        __builtin_amdgcn_s_sleep(1);
      }
    }
    unsigned* xsub = b.w + 1280 + 64 * b.x; unsigned* xgen = b.w + 2304 + 64 * b.x; unsigned* top = b.w + 3328; unsigned* topgen = b.w + 3392;
    const unsigned old = __hip_atomic_fetch_add(xsub, 1u, __ATOMIC_RELAXED, __HIP_MEMORY_SCOPE_AGENT);
    if (old + 1u == k * b.nloc) {
      __builtin_amdgcn_fence(__ATOMIC_RELEASE, "agent");
      asm volatile("s_waitcnt vmcnt(0)" ::: "memory");
      const unsigned og = __hip_atomic_fetch_add(top, 1u, __ATOMIC_RELAXED, __HIP_MEMORY_SCOPE_AGENT);
      if (og + 1u == k * b.nx) __hip_atomic_fetch_add(topgen, 1u, __ATOMIC_RELAXED, __HIP_MEMORY_SCOPE_AGENT);
      else while (__hip_atomic_load(topgen, __ATOMIC_RELAXED, __HIP_MEMORY_SCOPE_AGENT) < k) __builtin_amdgcn_s_sleep(1);
      __builtin_amdgcn_fence(__ATOMIC_ACQUIRE, "agent");
      __hip_atomic_fetch_add(xgen, 1u, __ATOMIC_RELAXED, __HIP_MEMORY_SCOPE_AGENT);
      asm volatile("s_waitcnt vmcnt(0)" ::: "memory");
    } else {
      while (__hip_atomic_load(xgen, __ATOMIC_RELAXED, __HIP_MEMORY_SCOPE_AGENT) < k) __builtin_amdgcn_s_sleep(1);
      __builtin_amdgcn_fence(__ATOMIC_ACQUIRE, "agent");
      asm volatile("s_waitcnt vmcnt(0)" ::: "memory");
    }
  }
  __syncthreads();
}

__global__ void __launch_bounds__(512) mega(Args a0) {
  extern __shared__ __attribute__((aligned(16))) unsigned char smem_raw[];
  float* smf = reinterpret_cast<float*>(smem_raw);
  cg::grid_group grid = cg::this_grid();
  const int tid = threadIdx.x;
  GBar gb; gb.w = reinterpret_cast<unsigned*>(a0.ws + O_BAR); gb.x = gb_xcc_id(); gb.nloc = 0u; gb.nx = 0u;
  if (threadIdx.x == 0) __hip_atomic_fetch_add(gb.w + 256 + 64 * gb.x, 1u, __ATOMIC_RELAXED, __HIP_MEMORY_SCOPE_AGENT);
  {
    for (int rep0 = 0; rep0 < (REP_PH == 0 ? 2 : 1); ++rep0) {
      if (rep0) grid.sync();
      PHASE_ARGS
      tconv(a.in[2], 1024, NIN, reinterpret_cast<bfu*>(ws + O_WINT), NINP, 1, smf);
      tconv(a.in[12], 1024, 1024, reinterpret_cast<bfu*>(ws + O_WOUTT), 1024, 0, smf);
      tconv(a.in[14], 1024, 4096, reinterpret_cast<bfu*>(ws + O_WUPT), 4096, 0, smf, a.in[13]);
      tconv(a.in[15], 4096, 1024, reinterpret_cast<bfu*>(ws + O_WDOWNT), 1024, 0, smf);
      tconv(a.in[7], 2048, 256, reinterpret_cast<bfu*>(ws + O_WK1T), 256, 0, smf);
      tconv(a.in[9], 2048, 256, reinterpret_cast<bfu*>(ws + O_WV1T), 256, 0, smf);
      tconv(a.in[8], 256, 64, reinterpret_cast<bfu*>(ws + O_WK2T), 128, 0, smf);
      tconv(a.in[10], 256, 64, reinterpret_cast<bfu*>(ws + O_WV2T), 128, 0, smf);
      {
        float4* z1 = reinterpret_cast<float4*>(ws + O_SS2);
        for (int i = blockIdx.x * 512 + tid; i < TT / 4; i += gridDim.x * 512) z1[i] = float4{0.f, 0.f, 0.f, 0.f};
      }
      if (blockIdx.x == 0 && tid < 64) {
        float wq = fabsf(a.in[3][tid]), w1 = fabsf(a.in[4][64 + tid]), w2 = fabsf(a.in[4][128 + tid]);
#pragma unroll
        for (int o = 32; o >= 1; o >>= 1) { wq = fmaxf(wq, __shfl_xor(wq, o)); w1 = fmaxf(w1, __shfl_xor(w1, o)); w2 = fmaxf(w2, __shfl_xor(w2, o)); }
        if (tid == 0) {
          float* cs_ = reinterpret_cast<float*>(ws + O_CSH);
          cs_[0] = fminf(8.f * wq * w1, 40.f) * LOG2E_C; cs_[1] = fminf(8.f * wq * w2, 40.f) * LOG2E_C;
        }
      }
      {
        float* rc = reinterpret_cast<float*>(ws + O_ROPEC);
        float* rs = reinterpret_cast<float*>(ws + O_ROPES);
        for (int i = blockIdx.x * 512 + tid; i < 2048 * 32; i += gridDim.x * 512) {
          const int s = i >> 5, f = i & 31;
          const float inv = powf(10000.f, -(float)f / 32.f);
          const float ang = (float)s * inv;
          const double ad = (double)ang;
          const double nrev = rint(ad * 0.15915494309189535);
          const float rr = (float)(ad - nrev * 6.283185307179586);
          rc[i] = __cosf(rr); rs[i] = __sinf(rr);
        }
      }
      for (int item = blockIdx.x; item < 128; item += gridDim.x) {
        const int kq = item & 15, nb = (item >> 4) & 3, kv = item >> 6;
        const float* pe = a.in[kv ? 6 : 5];
        const float* w1 = a.in[kv ? 9 : 7];
        const int tx = tid & 63, ty = tid >> 6;
        float sacc_ = 0.f;
#pragma unroll
        for (int i = 0; i < 16; ++i) {
          const int k = kq * 128 + ty * 16 + i;
          sacc_ += pe[k] * w1[(size_t)k * 256 + nb * 64 + tx];
        }
        __syncthreads();
        smf[ty * 64 + tx] = sacc_;
        __syncthreads();
        if (ty == 0) {
          float t_ = 0.f;
#pragma unroll
          for (int j = 0; j < 8; ++j) t_ += smf[j * 64 + tx];
          reinterpret_cast<float*>(ws + O_B1P)[(kv * 16 + kq) * 256 + nb * 64 + tx] = t_;
        }
      }
      rmsnorm_rows(a.in[0], a.in[1], reinterpret_cast<bfu*>(ws + O_XN));
    }
    if (a0.ph_lo == 0x7fffffff) grid.sync();
    gbar(gb, 1u);
    if (PH_ON(1)) phase1(a0.ws, a0.in[3], a0.in[4], a0.out);
    if (REP_PH == 1) { grid.sync(); phase1(a0.ws, a0.in[3], a0.in[4], a0.out); }
    gbar(gb, 2u);
    if (PH_ON(2)) phase2(a0.ws, nullptr, nullptr, a0.out);
    if (REP_PH == 23) { grid.sync(); phase2(a0.ws, nullptr, nullptr, a0.out); }
    gbar(gb, 3u);
    if (PH_ON(3)) phase3(a0.ws, nullptr, nullptr, a0.out);
    if (REP_PH == 23) { grid.sync(); phase3(a0.ws, nullptr, nullptr, a0.out); }
    gbar(gb, 4u);
    if (PH_ON(4)) phase4(a0.ws, a0.in[11], nullptr, a0.out);
    if (REP_PH == 4) { grid.sync(); phase4(a0.ws, a0.in[11], nullptr, a0.out); }
    gbar(gb, 5u);
    if (PH_ON(5)) phase5(a0.ws, a0.in[0], nullptr, a0.out);
    if (REP_PH == 5) { grid.sync(); phase5(a0.ws, a0.in[0], nullptr, a0.out); }
    gbar(gb, 6u);
    if (PH_ON(7)) phase7(a0.ws, nullptr, nullptr, a0.out);
    if (REP_PH == 7) { grid.sync(); phase7(a0.ws, nullptr, nullptr, a0.out); }
    gbar(gb, 7u);
    if (PH_ON(8)) phase8(a0.ws, nullptr, nullptr, a0.out);
    if (REP_PH == 100) { for (int i = 0; i < 8; ++i) grid.sync(); }
    if (REP_PH == 101) { for (unsigned i = 0; i < 8; ++i) gbar(gb, 8u + i); }
  }
}

extern "C" void kernel_launch(void* const* d_in, const int* in_sizes, int n_in, void* d_out, int out_size, void* d_ws, size_t ws_size,
                              hipStream_t stream) {
  static int grid_blocks = 0;
  if (!grid_blocks) {
    int dev = 0, cus = 0, per_cu = 0;
    hipGetDevice(&dev);
    hipDeviceGetAttribute(&cus, hipDeviceAttributeMultiprocessorCount, dev);
    hipFuncSetAttribute((const void*)mega, hipFuncAttributeMaxDynamicSharedMemorySize, SMEM_BYTES);
    hipOccupancyMaxActiveBlocksPerMultiprocessor(&per_cu, (const void*)mega, 512, SMEM_BYTES);
    if (per_cu < 1) per_cu = 1;
    if (per_cu > 1) per_cu = 1;
    grid_blocks = cus * per_cu;
    if (ws_size < O_END) fprintf(stderr, "workspace too small: %zu < %zu\n", ws_size, (size_t)O_END);
  }
  Args a{};
  for (int i = 0; i < 16; ++i) a.in[i] = (const float*)d_in[i];
  a.out = (float*)d_out;
  a.ws = (unsigned char*)d_ws;
  a.ph_lo = 0; a.ph_hi = 9;
  (void)hipMemsetAsync((unsigned char*)d_ws + O_BAR, 0, 16384, stream);
  void* args[] = {&a};
  hipError_t e = hipLaunchCooperativeKernel((const void*)mega, dim3(grid_blocks), dim3(512), args, SMEM_BYTES, stream);
  if (e != hipSuccess) fprintf(stderr, "cooperative launch failed: %s (grid %d)\n", hipGetErrorString(e), grid_blocks);
}
```
